# Optimizing an MI355X kernel written in HIP

```python
import math
import jax
import jax.numpy as jnp
from jax import lax
import numpy as np

D_MODEL = 2048
BATCH = 8
SEQ = 2048
DEPTH = 2
DEC_BATCH = 128
DEC_SEQ = 1
PAST_LEN = 8192
PAGE_SIZE = 128

MIX_WIDTH = D_MODEL
N_MEM = 256
MEM_HEADS = 4
MEM_HD = 128
MEM_Q_DIM = MEM_HEADS * MEM_HD
WINDOW = 128
SWA_HD = 64
SWA_Q_HEADS = (MIX_WIDTH - MEM_Q_DIM) // SWA_HD
SWA_KV_HEADS = 4
SWA_GROUP = SWA_Q_HEADS // SWA_KV_HEADS
SWA_Q_DIM = SWA_Q_HEADS * SWA_HD
SWA_KV_DIM = SWA_KV_HEADS * SWA_HD
N_BUCKETS = 32
MAX_DISTANCE = WINDOW
HG_DK = 128
HG_DV = 128
HG_HEADS = (MIX_WIDTH - MEM_Q_DIM) // HG_DV
HG_K_DIM = HG_HEADS * HG_DK
HG_V_DIM = HG_HEADS * HG_DV
HG_CHUNK = 64
N_SWA_LAYERS = (DEPTH + 1) // 2
N_HG_LAYERS = DEPTH // 2
SWA_SPLITS = (SWA_Q_DIM, SWA_KV_DIM, SWA_KV_DIM, MEM_Q_DIM, MIX_WIDTH)
HG_SPLITS = (HG_K_DIM, HG_K_DIM, HG_V_DIM, MEM_Q_DIM, MIX_WIDTH)
DEEPNORM_ALPHA = (2.0 * DEPTH) ** 0.25
DEEPNORM_BETA = (8.0 * DEPTH) ** -0.25
LN_EPS = 1e-5
RMS_EPS = 1e-6

kernel_name = 'swa_sink_hgrn2_memxattn_hybrid_step'


def _split(u, sizes):
    offs = [int(o) for o in np.cumsum(sizes)[:-1]]
    return jnp.split(u, offs, axis=-1)


def _layer_norm(x, w, b):
    xf = x.astype(jnp.float32)
    mu = jnp.mean(xf, axis=-1, keepdims=True)
    var = jnp.mean(jnp.square(xf - mu), axis=-1, keepdims=True)
    y = (xf - mu) * lax.rsqrt(var + LN_EPS) * w.astype(jnp.float32) + b.astype(jnp.float32)
    return y.astype(x.dtype)


def _t5_bucket(d):
    n = jnp.maximum(d, 0)
    max_exact = N_BUCKETS // 2
    nf = jnp.maximum(n, 1).astype(jnp.float32)
    large = max_exact + (jnp.log(nf / max_exact) / math.log(MAX_DISTANCE / max_exact)
                         * (N_BUCKETS - max_exact)).astype(jnp.int32)
    large = jnp.minimum(large, N_BUCKETS - 1)
    return jnp.where(n < max_exact, n, large)


def _banded_attend(qb, kb, vb, d, valid, sinks, rel_bias):
    n, nq, nk = d.shape
    bias = rel_bias.astype(jnp.float32)[_t5_bucket(d)]
    bias = jnp.transpose(bias, (0, 3, 1, 2)).reshape(n, SWA_KV_HEADS, SWA_GROUP, nq, nk)
    mask = valid & (d >= 0) & (d < WINDOW)
    s = jnp.einsum('bnqhgd,bnkhd->bnhgqk', qb, kb).astype(jnp.float32) * (SWA_HD ** -0.5) + bias[None]
    s = jnp.where(mask[None, :, None, None], s, -jnp.inf)
    sink = sinks.astype(jnp.float32).reshape(1, 1, SWA_KV_HEADS, SWA_GROUP, 1, 1)
    m = jnp.maximum(jnp.max(s, axis=-1, keepdims=True), sink)
    p = jnp.exp(s - m)
    p = p / (jnp.sum(p, axis=-1, keepdims=True) + jnp.exp(sink - m))
    return jnp.einsum('bnhgqk,bnkhd->bnqhgd', p.astype(vb.dtype), vb)


def _swa_prompt(q, k, v, sinks, rel_bias):
    b, t = q.shape[:2]
    nb = t // WINDOW
    qb = q.reshape(b, nb, WINDOW, SWA_KV_HEADS, SWA_GROUP, SWA_HD)
    kc = k.reshape(b, nb, WINDOW, SWA_KV_HEADS, SWA_HD)
    vc = v.reshape(b, nb, WINDOW, SWA_KV_HEADS, SWA_HD)

    def prev(a):
        return jnp.pad(a, ((0, 0), (1, 0), (0, 0), (0, 0), (0, 0)))[:, :-1]

    kb = jnp.concatenate([prev(kc), kc], axis=2)
    vb = jnp.concatenate([prev(vc), vc], axis=2)
    blk = jnp.arange(nb)[:, None, None] * WINDOW
    qpos = blk + jnp.arange(WINDOW)[None, :, None]
    kpos = blk - WINDOW + jnp.arange(2 * WINDOW)[None, None, :]
    o = _banded_attend(qb, kb, vb, qpos - kpos, kpos >= 0, sinks, rel_bias)
    keep = min(WINDOW, t)
    return o.reshape(b, t, SWA_Q_DIM), k[:, t - keep:], v[:, t - keep:]


def _swa_sample(q, k, v, buf_k, buf_v, sinks, rel_bias):
    b, t = q.shape[:2]
    nbuf = buf_k.shape[1]
    kk = jnp.concatenate([buf_k.astype(k.dtype), k], axis=1)
    vv = jnp.concatenate([buf_v.astype(v.dtype), v], axis=1)
    qpos = PAST_LEN + jnp.arange(t)
    kpos = PAST_LEN - nbuf + jnp.arange(nbuf + t)
    d = (qpos[:, None] - kpos[None, :])[None]
    valid = (kpos >= 0)[None, None, :]
    qb = q.reshape(b, 1, t, SWA_KV_HEADS, SWA_GROUP, SWA_HD)
    o = _banded_attend(qb, kk[:, None], vv[:, None], d, valid, sinks, rel_bias)
    return o.reshape(b, t, SWA_Q_DIM), kk[:, -nbuf:], vv[:, -nbuf:]


def _hgrn2_chunked(q, k, v, logf, s0):
    b, t, h, dk = q.shape
    dv = v.shape[-1]
    c = HG_CHUNK if t % HG_CHUNK == 0 else t
    n = t // c

    def blocks(a):
        return jnp.moveaxis(a.reshape(b, n, c, h, a.shape[-1]), 1, 0)

    causal = jnp.tril(jnp.ones((c, c), dtype=bool))[None, :, :, None, None]

    def step(state, xs):
        qc, kc, vc, gc = xs
        g_cum = jnp.cumsum(gc, axis=1)
        diff = g_cum[:, :, None] - g_cum[:, None, :]
        decay = jnp.exp(jnp.where(causal, diff, -jnp.inf))
        scores = jnp.einsum('bthk,btshk,bshk->bhts', qc, decay, kc)
        o = (jnp.einsum('bhts,bshv->bthv', scores, vc)
             + jnp.einsum('bthk,bhkv->bthv', qc * jnp.exp(g_cum), state))
        g_last = g_cum[:, -1]
        k_dec = kc * jnp.exp(g_last[:, None] - g_cum)
        state = jnp.exp(g_last)[..., None] * state + jnp.einsum('bshk,bshv->bhkv', k_dec, vc)
        return state, o

    s_fin, o = lax.scan(step, s0, (blocks(q), blocks(k), blocks(v), blocks(logf)))
    return jnp.moveaxis(o, 0, 1).reshape(b, t, h, dv), s_fin


def _swa_proj(h, w_in):
    b, t = h.shape[:2]
    q, k, v, mq, g = _split(jnp.einsum('btd,de->bte', h, w_in), SWA_SPLITS)
    return (q.reshape(b, t, SWA_Q_HEADS, SWA_HD), k.reshape(b, t, SWA_KV_HEADS, SWA_HD),
            v.reshape(b, t, SWA_KV_HEADS, SWA_HD), mq, g)


def _hgrn_branch(h, w_in, lb, norm_w, s0):
    b, t = h.shape[:2]
    q, f, iv, mq, g = _split(jnp.einsum('btd,de->bte', h, w_in), HG_SPLITS)
    fg = lb[None, None, :] + (1.0 - lb[None, None, :]) * jax.nn.sigmoid(f.astype(jnp.float32))
    qh = jax.nn.silu(q.astype(jnp.float32)).reshape(b, t, HG_HEADS, HG_DK)
    kh = (1.0 - fg).reshape(b, t, HG_HEADS, HG_DK)
    gh = jnp.log(fg).reshape(b, t, HG_HEADS, HG_DK)
    vh = iv.astype(jnp.float32).reshape(b, t, HG_HEADS, HG_DV)
    o, s_new = _hgrn2_chunked(qh, kh, vh, gh, s0.astype(jnp.float32))
    o = o * lax.rsqrt(jnp.mean(jnp.square(o), axis=-1, keepdims=True) + RMS_EPS) \
        * norm_w.astype(jnp.float32).reshape(HG_HEADS, HG_DV)
    return o.reshape(b, t, HG_V_DIM).astype(h.dtype), s_new, mq, g


def _mem_attend(mq, mk, mv):
    s = jnp.einsum('bthd,bmhd->bhtm', mq, mk).astype(jnp.float32) * (MEM_HD ** -0.5)
    p = jax.nn.softmax(s, axis=-1)
    return jnp.einsum('bhtm,bmhd->bthd', p.astype(mv.dtype), mv)


def _finish(h, mix, mq, g, mk, mv, w_out_i, ln_w_i, ln_b_i):
    b, t = h.shape[:2]
    mem_o = _mem_attend(mq.reshape(b, t, MEM_HEADS, MEM_HD), mk.astype(mq.dtype), mv.astype(mq.dtype))
    branch = jnp.concatenate([mix.astype(h.dtype), mem_o.reshape(b, t, MEM_Q_DIM).astype(h.dtype)], axis=-1) \
        * jax.nn.silu(g)
    y = jnp.einsum('bte,ed->btd', branch, w_out_i)
    return _layer_norm(DEEPNORM_ALPHA * h + y, ln_w_i, ln_b_i)


def setup_inputs(seed: int = 0) -> dict:
    key = jax.random.key(seed)
    ks = jax.random.split(key, 20)

    def nrm(k, shape, scale=1.0):
        return jax.random.normal(k, shape, jnp.float32) * scale

    win_buf = min(WINDOW, PAST_LEN)
    d_in = D_MODEL ** -0.5
    return {
        'x_prompt': nrm(ks[0], (BATCH, SEQ, D_MODEL)),
        'x_sample': nrm(ks[1], (DEC_BATCH, DEC_SEQ, D_MODEL)),
        'cache_mem_k': nrm(ks[2], (DEPTH, DEC_BATCH, N_MEM, MEM_HEADS, MEM_HD)),
        'cache_mem_v': nrm(ks[3], (DEPTH, DEC_BATCH, N_MEM, MEM_HEADS, MEM_HD)),
        'cache_swa_k': nrm(ks[4], (N_SWA_LAYERS, DEC_BATCH, win_buf, SWA_KV_HEADS, SWA_HD)),
        'cache_swa_v': nrm(ks[5], (N_SWA_LAYERS, DEC_BATCH, win_buf, SWA_KV_HEADS, SWA_HD)),
        'state_hgrn': nrm(ks[6], (N_HG_LAYERS, DEC_BATCH, HG_HEADS, HG_DK, HG_DV), 0.5),
        'mem_prompt': nrm(ks[7], (BATCH, N_MEM, D_MODEL)),
        'rel_bias': nrm(ks[8], (N_BUCKETS, SWA_Q_HEADS), 0.5),
        'swa_w_in': nrm(ks[9], (N_SWA_LAYERS, D_MODEL, sum(SWA_SPLITS)), d_in),
        'swa_sinks': nrm(ks[10], (N_SWA_LAYERS, SWA_Q_HEADS), 0.5),
        'hg_w_in': nrm(ks[11], (N_HG_LAYERS, D_MODEL, sum(HG_SPLITS)), d_in),
        'hg_lb_logits': nrm(ks[12], (DEPTH, HG_K_DIM)),
        'hg_norm_w': 1.0 + nrm(ks[13], (N_HG_LAYERS, HG_V_DIM), 0.02),
        'w_mem_k': nrm(ks[14], (DEPTH, D_MODEL, MEM_Q_DIM), d_in),
        'w_mem_v': nrm(ks[15], (DEPTH, D_MODEL, MEM_Q_DIM), d_in),
        'w_out': nrm(ks[16], (DEPTH, MIX_WIDTH, D_MODEL), DEEPNORM_BETA * MIX_WIDTH ** -0.5),
        'ln_w': 1.0 + nrm(ks[17], (DEPTH, D_MODEL), 0.02),
        'ln_b': nrm(ks[18], (DEPTH, D_MODEL), 0.02),
    }


def reference(x_prompt, x_sample, cache_mem_k, cache_mem_v, cache_swa_k, cache_swa_v, state_hgrn, mem_prompt,
              rel_bias, swa_w_in, swa_sinks, hg_w_in, hg_lb_logits, hg_norm_w, w_mem_k, w_mem_v, w_out, ln_w, ln_b):
    lb_all = jnp.cumsum(jax.nn.softmax(hg_lb_logits.astype(jnp.float32), axis=0), axis=0)
    lb_all = lb_all - lb_all[0:1]
    bp = x_prompt.shape[0]
    hp, hs = x_prompt, x_sample
    mk_list, mv_list = [], []
    swa_kp, swa_vp, swa_ks, swa_vs = [], [], [], []
    hg_sp, hg_ss = [], []
    for i in range(DEPTH):
        mk_p = jnp.einsum('bmd,de->bme', mem_prompt, w_mem_k[i]).reshape(bp, N_MEM, MEM_HEADS, MEM_HD)
        mv_p = jnp.einsum('bmd,de->bme', mem_prompt, w_mem_v[i]).reshape(bp, N_MEM, MEM_HEADS, MEM_HD)
        mk_list.append(mk_p)
        mv_list.append(mv_p)
        j = i // 2
        if i % 2 == 0:
            q, k, v, mq, g = _swa_proj(hp, swa_w_in[j])
            mix, kw, vw = _swa_prompt(q, k, v, swa_sinks[j], rel_bias)
            hp = _finish(hp, mix, mq, g, mk_p, mv_p, w_out[i], ln_w[i], ln_b[i])
            swa_kp.append(kw)
            swa_vp.append(vw)
            q, k, v, mq, g = _swa_proj(hs, swa_w_in[j])
            mix, kw, vw = _swa_sample(q, k, v, cache_swa_k[j], cache_swa_v[j], swa_sinks[j], rel_bias)
            hs = _finish(hs, mix, mq, g, cache_mem_k[i], cache_mem_v[i], w_out[i], ln_w[i], ln_b[i])
            swa_ks.append(kw.astype(cache_swa_k.dtype))
            swa_vs.append(vw.astype(cache_swa_v.dtype))
        else:
            s0 = jnp.zeros((bp, HG_HEADS, HG_DK, HG_DV), jnp.float32)
            mix, s_new, mq, g = _hgrn_branch(hp, hg_w_in[j], lb_all[i], hg_norm_w[j], s0)
            hp = _finish(hp, mix, mq, g, mk_p, mv_p, w_out[i], ln_w[i], ln_b[i])
            hg_sp.append(s_new.astype(x_prompt.dtype))
            mix, s_new, mq, g = _hgrn_branch(hs, hg_w_in[j], lb_all[i], hg_norm_w[j], state_hgrn[j])
            hs = _finish(hs, mix, mq, g, cache_mem_k[i], cache_mem_v[i], w_out[i], ln_w[i], ln_b[i])
            hg_ss.append(s_new.astype(state_hgrn.dtype))
    mem_k_prompt = jnp.stack(mk_list)
    mem_v_prompt = jnp.stack(mv_list)
    swa_k_prompt = jnp.stack(swa_kp)
    swa_v_prompt = jnp.stack(swa_vp)
    hgrn_state_prompt = jnp.stack(hg_sp)
    swa_k_sample = jnp.stack(swa_ks)
    swa_v_sample = jnp.stack(swa_vs)
    hgrn_state_sample = jnp.stack(hg_ss)
    return (hp, hs, mem_k_prompt, mem_v_prompt, swa_k_prompt, swa_v_prompt, hgrn_state_prompt,
            swa_k_sample, swa_v_sample, hgrn_state_sample)
```

```cpp
#include <hip/hip_runtime.h>
#include <hip/hip_cooperative_groups.h>
#include <cstdio>
#include <cstdint>
namespace cg = cooperative_groups;
namespace pg8 {
#define PG8_LAS __attribute__((address_space(3)))
typedef unsigned short bf16_t;
typedef short bf16x8 __attribute__((ext_vector_type(8)));
typedef float f32x4 __attribute__((ext_vector_type(4)));
typedef unsigned u32x4 __attribute__((ext_vector_type(4)));
constexpr int BM = 256, BK = 64, HALF = 128, HTB = HALF * BK * 2  , STAGE_BYTES = 8 * HTB, NXCD = 8, WGM = 8;

__host__ __device__ __forceinline__ int lds_byte(int r, int c) { const int st = (r >> 4) * 2 + (c >> 5), rr = r & 15, cc = c & 31, ob = rr * 64 + cc * 2; return st * 1024 + (ob ^ (((ob >> 9) & 1) << 5)); }
__host__ __device__ __forceinline__ void stage_rc(int b, int& R, int& C) { const int st = b / 1024, sb = b % 1024, swz = sb ^ (((sb >> 9) & 1) << 5); R = (st >> 1) * 16 + swz / 64; C = (st & 1) * 32 + (swz % 64) / 2; }
__host__ __device__ __forceinline__ int perm32(int rho) { const int n = rho >> 4, i = rho & 15; return 8 * (i >> 2) + 4 * n + (i & 3); }

struct Unit { int pm, pn; };
struct Gemm { const bf16_t* A; const bf16_t* Bt; int M, N, K; };

struct StaticOrder {
    int nM, nN, nwg, G, c;
    __host__ __device__ void init(int M, int N, int G_, int c_) { nM = M / BM; nN = N / BM; nwg = nM * nN; G = G_; c = c_; }
    __host__ __device__ bool next(int i, Unit& u) const {
        const long L = (long)i * G + c; if (L >= nwg) return false;
        int wgid = (int)L; { const int q = nwg / NXCD, r = nwg % NXCD, xcd = wgid % NXCD, off = wgid / NXCD; wgid = (xcd < r ? xcd * (q + 1) : r * (q + 1) + (xcd - r) * q) + off; }
        const int nig = WGM * nN, gid = wgid / nig, fm = gid * WGM, gsz = (nM - fm) < WGM ? (nM - fm) : WGM;
        u.pm = fm + ((wgid % nig) % gsz); u.pn = (wgid % nig) / gsz; return true;
    }
    __device__ __forceinline__ void a_ready(const Unit&) const {}
    __device__ __forceinline__ void done(const Unit&) const {}
};

__device__ __forceinline__ unsigned cvt_pk_bf16(float lo, float hi) { unsigned r; asm volatile("v_cvt_pk_bf16_f32 %0, %1, %2" : "=v"(r) : "v"(lo), "v"(hi)); return r; }
typedef float f32x2 __attribute__((ext_vector_type(2)));
__device__ __forceinline__ f32x2 gelu_pk(f32x2 v) {
    const f32x2 av = __builtin_elementwise_abs(v), d = av * 0.2316418882f + 1.0f;
    f32x2 t; t.x = __builtin_amdgcn_rcpf(d.x); t.y = __builtin_amdgcn_rcpf(d.y);
    f32x2 q = t * 0.5307027145f + (-0.7265760135f); q = q * t + 0.7107068705f; q = q * t + (-0.142248368f); q = q * t + 0.127414796f; q = q * t;
    const f32x2 s = (v * v) * (-0.72134752044f);
    f32x2 e; e.x = __builtin_amdgcn_exp2f(s.x); e.y = __builtin_amdgcn_exp2f(s.y);
    const f32x2 m = v * (q * e), r = v - m;
    f32x2 o; o.x = v.x < 0.f ? m.x : r.x; o.y = v.y < 0.f ? m.y : r.y; return o;
}


struct EpiProj {
    static constexpr bool PERM = true, AFTER_DRAIN = false;
    bf16_t* U; int ldu; int n_main_pn; int mem_pm0; float* memf; bf16_t* memb;
    __device__ __forceinline__ void operator()(const f32x4 (&acc)[2][2][4][2], const Unit& u, int wr, int wc, int fr, int fq) const {
        if (u.pn < n_main_pn) {
            const int row0 = u.pm * BM + wr * 64 + fr, col0 = u.pn * BM + wc * 32 + 8 * fq;
#pragma unroll
            for (int ai = 0; ai < 2; ++ai)
#pragma unroll
                for (int m = 0; m < 4; ++m) { bf16_t* rowp = U + (size_t)(row0 + ai * HALF + m * 16) * ldu + col0;
#pragma unroll
                    for (int bj = 0; bj < 2; ++bj) { const f32x4 v0 = acc[ai][bj][m][0], v1 = acc[ai][bj][m][1]; u32x4 w;
                        w.x = cvt_pk_bf16(v0[0], v0[1]); w.y = cvt_pk_bf16(v0[2], v0[3]); w.z = cvt_pk_bf16(v1[0], v1[1]); w.w = cvt_pk_bf16(v1[2], v1[3]);
                        __builtin_nontemporal_store(w, (u32x4*)(rowp + bj * HALF)); } }
        } else {
            const int t = (u.pn - n_main_pn) >> 1, colt = ((u.pn - n_main_pn) & 1) * 256;
            const int row0 = (u.pm - mem_pm0) * BM + wr * 64 + fr, col0 = colt + wc * 32 + 8 * fq;
            float* fb = memf + (size_t)t * (2048 * 512); bf16_t* bb = memb + (size_t)t * (2048 * 512);
#pragma unroll
            for (int ai = 0; ai < 2; ++ai)
#pragma unroll
                for (int m = 0; m < 4; ++m) { const size_t ro = (size_t)(row0 + ai * HALF + m * 16) * 512 + col0;
#pragma unroll
                    for (int bj = 0; bj < 2; ++bj) { const f32x4 v0 = acc[ai][bj][m][0], v1 = acc[ai][bj][m][1]; u32x4 w;
                        __builtin_nontemporal_store(v0, (f32x4*)(fb + ro + bj * HALF)); __builtin_nontemporal_store(v1, (f32x4*)(fb + ro + bj * HALF + 4));
                        w.x = cvt_pk_bf16(v0[0], v0[1]); w.y = cvt_pk_bf16(v0[2], v0[3]); w.z = cvt_pk_bf16(v1[0], v1[1]); w.w = cvt_pk_bf16(v1[2], v1[3]);
                        *(u32x4*)(bb + ro + bj * HALF) = w; } }
        }
    }
};
struct EpiOut {
    static constexpr bool PERM = true, AFTER_DRAIN = false;
    bf16_t* Z; int mode; const bf16_t* xb; const bf16_t* zprev; const float* stats; const float* lnw; const float* lnb; float alpha;
    __device__ __forceinline__ static void unpack8(const u32x4 w, f32x4& lo, f32x4& hi) {
        lo = (f32x4){__uint_as_float(w.x << 16), __uint_as_float(w.x & 0xffff0000u), __uint_as_float(w.y << 16), __uint_as_float(w.y & 0xffff0000u)};
        hi = (f32x4){__uint_as_float(w.z << 16), __uint_as_float(w.z & 0xffff0000u), __uint_as_float(w.w << 16), __uint_as_float(w.w & 0xffff0000u)}; }
    __device__ __forceinline__ void operator()(const f32x4 (&acc)[2][2][4][2], const Unit& u, int wr, int wc, int fr, int fq) const {
        const int row0 = u.pm * BM + wr * 64 + fr, col0 = u.pn * BM + wc * 32 + 8 * fq;
        f32x4 lw[2][2], lb[2][2];
        if (mode == 1) {
#pragma unroll
            for (int bj = 0; bj < 2; ++bj) { lw[bj][0] = *(const f32x4*)(lnw + col0 + bj * HALF); lw[bj][1] = *(const f32x4*)(lnw + col0 + bj * HALF + 4);
                lb[bj][0] = *(const f32x4*)(lnb + col0 + bj * HALF); lb[bj][1] = *(const f32x4*)(lnb + col0 + bj * HALF + 4); }
        }
        const bf16_t* src = mode == 1 ? zprev : xb;
#pragma unroll
        for (int ai = 0; ai < 2; ++ai)
#pragma unroll
            for (int m = 0; m < 4; ++m) { const int row = row0 + ai * HALF + m * 16; const size_t ro = (size_t)row * 2048 + col0;
                float mu = 0.f, rs = 1.f; if (mode == 1) { mu = stats[2 * row]; rs = stats[2 * row + 1]; }
#pragma unroll
                for (int bj = 0; bj < 2; ++bj) { f32x4 r0, r1; unpack8(*(const u32x4*)(src + ro + bj * HALF), r0, r1);
                    if (mode == 1) { r0 = (r0 - mu) * rs * lw[bj][0] + lb[bj][0]; r1 = (r1 - mu) * rs * lw[bj][1] + lb[bj][1]; }
                    const f32x4 v0 = r0 * alpha + acc[ai][bj][m][0], v1 = r1 * alpha + acc[ai][bj][m][1]; u32x4 w;
                    w.x = cvt_pk_bf16(v0[0], v0[1]); w.y = cvt_pk_bf16(v0[2], v0[3]); w.z = cvt_pk_bf16(v1[0], v1[1]); w.w = cvt_pk_bf16(v1[2], v1[3]);
                    *(u32x4*)(Z + ro + bj * HALF) = w; } }
    }
};
struct OrderExt {
    StaticOrder so; int n_main, n_ext, ext_pm0, ext_pn0, ext_nm;
    __host__ __device__ void init(int M, int N, int G_, int c_, int n_ext_, int ext_pm0_, int ext_pn0_, int ext_nm_) { so.init(M, N, G_, c_); n_main = so.nwg; n_ext = n_ext_; ext_pm0 = ext_pm0_; ext_pn0 = ext_pn0_; ext_nm = ext_nm_; }
    __host__ __device__ bool next(int i, Unit& u) const {
        const long L = (long)i * so.G + so.c;
        if (L < n_main) return so.next(i, u);
        const int e = (int)(L - n_main); if (e >= n_ext) return false;
        u.pm = ext_pm0 + e % ext_nm; u.pn = ext_pn0 + e / ext_nm; return true;
    }
    __device__ __forceinline__ void a_ready(const Unit&) const {}
    __device__ __forceinline__ void done(const Unit&) const {}
};
template <class Epi, class Sched, bool ALIGN_EPI = false, bool SP2 = false>
__device__ __forceinline__ void gemm_phase(PG8_LAS unsigned char* lds, const Gemm g, const Sched& S, const Epi& E) {
    const int tid = threadIdx.x, wid = __builtin_amdgcn_readfirstlane(tid >> 6), lane = tid & 63, wr = wid >> 2, wc = wid & 3, fr = lane & 15, fq = lane >> 4;
    const int K = g.K, nt = K / BK;
    unsigned voffA[2], voffB[2];
#pragma unroll
    for (int i = 0; i < 2; ++i) { int R, C; stage_rc(tid * 16 + i * 8192, R, C); const int Rb = Epi::PERM ? ((R & ~31) + perm32(R & 31)) : R;
        voffA[i] = (unsigned)(R * K + C) * 2u; voffB[i] = (unsigned)(Rb * K + C) * 2u; }
    const size_t kstep = (size_t)(BK * 2);
    const size_t hstep = (size_t)HALF * K * 2;
    const size_t tstep = 2 * hstep;
    const unsigned ldsw = (unsigned)wid * 1024u;
    const int aoff = lds_byte(wr * 64 + fr, fq * 8), boff = lds_byte(wc * 32 + fr, fq * 8);
#define PG8_SA(b, h) (((b) * 2 + (h)) * HTB)
#define PG8_SB(b, h) ((4 + (b) * 2 + (h)) * HTB)
#define PG8_STAGE(bufoff, gbase, voff) do { _Pragma("unroll") for (int _i = 0; _i < 2; ++_i) \
        __builtin_amdgcn_global_load_lds((const unsigned*)((const char*)(gbase) + (voff)[_i]), (PG8_LAS unsigned*)(lds + (bufoff) + ldsw + _i * 8192), 16, 0, 0); } while (0)
#define PG8_LDA(dst, b, h) do { _Pragma("unroll") for (int m = 0; m < 4; ++m) _Pragma("unroll") for (int k = 0; k < 2; ++k) dst[m][k] = *(const PG8_LAS bf16x8*)(lds + PG8_SA(b, h) + aoff + m * 2048 + k * 1024); } while (0)
#define PG8_LDB(dst, b, h) do { _Pragma("unroll") for (int n = 0; n < 2; ++n) _Pragma("unroll") for (int k = 0; k < 2; ++k) dst[n][k] = *(const PG8_LAS bf16x8*)(lds + PG8_SB(b, h) + boff + n * 2048 + k * 1024); } while (0)
#define PG8_MMA(ai, bj, At, Bt) do { __builtin_amdgcn_s_setprio(1); _Pragma("unroll") for (int m = 0; m < 4; ++m) _Pragma("unroll") for (int n = 0; n < 2; ++n) _Pragma("unroll") for (int k = 0; k < 2; ++k) \
        acc[ai][bj][m][n] = __builtin_amdgcn_mfma_f32_16x16x32_bf16(Bt[n][k], At[m][k], acc[ai][bj][m][n], 0, 0, 0); __builtin_amdgcn_s_setprio(0); } while (0)
#define PG8_WAIT_V(n) asm volatile("s_waitcnt vmcnt(" #n ")" ::: "memory")
#define PG8_WAIT_L(n) asm volatile("s_waitcnt lgkmcnt(" #n ")" ::: "memory")
#define PG8_BAR __builtin_amdgcn_s_barrier()
#define PG8_SCHED __builtin_amdgcn_sched_barrier(0)
    Unit cur, nxt; int ui = 0;
    if (!S.next(0, cur)) return;
    f32x4 acc[2][2][4][2];
#pragma unroll
    for (int a = 0; a < 2; ++a)
#pragma unroll
        for (int b = 0; b < 2; ++b)
#pragma unroll
            for (int m = 0; m < 4; ++m)
#pragma unroll
                for (int n = 0; n < 2; ++n) acc[a][b][m][n] = (f32x4){0.f, 0.f, 0.f, 0.f};
    bf16x8 At[4][2], B0[2][2], B1[2][2];
    const char* cA = (const char*)g.A + (size_t)cur.pm * tstep; const char* cB = (const char*)g.Bt + (size_t)cur.pn * tstep;
    S.a_ready(cur);
    if constexpr (SP2) {
        PG8_STAGE(PG8_SB(0, 0), cB, voffB); PG8_STAGE(PG8_SB(0, 1), cB + hstep, voffB); PG8_STAGE(PG8_SA(0, 0), cA, voffA); PG8_STAGE(PG8_SA(0, 1), cA + hstep, voffA);
        if (wr == 1) PG8_BAR;
        PG8_WAIT_V(2); PG8_BAR;
        PG8_STAGE(PG8_SB(1, 0), cB + kstep, voffB); PG8_STAGE(PG8_SA(1, 0), cA + kstep, voffA); PG8_STAGE(PG8_SB(1, 1), cB + hstep + kstep, voffB);
        PG8_WAIT_V(6); PG8_BAR;
    } else {
        PG8_STAGE(PG8_SB(0, 0), cB, voffB); PG8_STAGE(PG8_SA(0, 0), cA, voffA); PG8_STAGE(PG8_SB(0, 1), cB + hstep, voffB); PG8_STAGE(PG8_SA(0, 1), cA + hstep, voffA);
        if (wr == 1) PG8_BAR;
        PG8_WAIT_V(4); PG8_BAR;
        PG8_STAGE(PG8_SB(1, 0), cB + kstep, voffB); PG8_STAGE(PG8_SA(1, 0), cA + kstep, voffA); PG8_STAGE(PG8_SB(1, 1), cB + hstep + kstep, voffB);
        PG8_WAIT_V(6); PG8_BAR;
    }
    for (;;) {
        const bool has_next = S.next(ui + 1, nxt);
        const char* nA = has_next ? (const char*)g.A + (size_t)nxt.pm * tstep : cA; const char* nB = has_next ? (const char*)g.Bt + (size_t)nxt.pn * tstep : cB;
        for (int t = 0; t < nt; t += 2) {
            const bool last = (t == nt - 2);
            const char* a1 = cA + (size_t)(t + 1) * kstep;
            const char* a2 = last ? nA : cA + (size_t)(t + 2) * kstep; const char* b2 = last ? nB : cB + (size_t)(t + 2) * kstep;
            const char* a3 = a2 + kstep; const char* b3 = b2 + kstep;
            if (last && has_next) S.a_ready(nxt);
            if constexpr (SP2) {
            PG8_LDB(B0, 0, 0); PG8_LDB(B1, 0, 1); PG8_SCHED; PG8_LDA(At, 0, 0); PG8_STAGE(PG8_SA(1, 1), a1 + hstep, voffA);
            PG8_WAIT_V(8); PG8_WAIT_L(0); PG8_BAR; PG8_MMA(0, 0, At, B0); PG8_MMA(0, 1, At, B1); PG8_BAR; PG8_SCHED;
            PG8_LDA(At, 0, 1); PG8_STAGE(PG8_SB(0, 0), b2, voffB); PG8_STAGE(PG8_SB(0, 1), b2 + hstep, voffB); PG8_STAGE(PG8_SA(0, 0), a2, voffA);
            PG8_WAIT_V(8); PG8_WAIT_L(0); PG8_BAR; PG8_MMA(1, 0, At, B0); PG8_MMA(1, 1, At, B1); PG8_BAR; PG8_SCHED;
            PG8_LDB(B0, 1, 0); PG8_LDB(B1, 1, 1); PG8_SCHED; PG8_LDA(At, 1, 0); PG8_STAGE(PG8_SA(0, 1), a2 + hstep, voffA);
            PG8_WAIT_V(8); PG8_WAIT_L(0); PG8_BAR; PG8_MMA(0, 0, At, B0); PG8_MMA(0, 1, At, B1); PG8_BAR; PG8_SCHED;
            PG8_LDA(At, 1, 1); PG8_STAGE(PG8_SB(1, 0), b3, voffB); PG8_STAGE(PG8_SB(1, 1), b3 + hstep, voffB); PG8_STAGE(PG8_SA(1, 0), a3, voffA);
            PG8_WAIT_V(8); PG8_WAIT_L(0); PG8_BAR; PG8_MMA(1, 0, At, B0); PG8_MMA(1, 1, At, B1); PG8_BAR; PG8_SCHED;
            } else {
            PG8_LDB(B0, 0, 0); PG8_SCHED; PG8_LDA(At, 0, 0); PG8_STAGE(PG8_SA(1, 1), a1 + hstep, voffA);
            PG8_WAIT_L(8); PG8_BAR; PG8_WAIT_L(0); PG8_MMA(0, 0, At, B0); PG8_BAR; PG8_SCHED;
            PG8_LDB(B1, 0, 1); PG8_STAGE(PG8_SB(0, 0), b2, voffB);
            PG8_BAR; PG8_WAIT_L(0); PG8_MMA(0, 1, At, B1); PG8_BAR;
            PG8_LDA(At, 0, 1); PG8_STAGE(PG8_SA(0, 0), a2, voffA);
            PG8_BAR; PG8_WAIT_L(0); PG8_MMA(1, 0, At, B0); PG8_BAR; PG8_SCHED;
            PG8_STAGE(PG8_SB(0, 1), b2 + hstep, voffB);
            PG8_WAIT_V(6); PG8_BAR; PG8_MMA(1, 1, At, B1); PG8_BAR;
            PG8_LDB(B0, 1, 0); PG8_SCHED; PG8_LDA(At, 1, 0); PG8_STAGE(PG8_SA(0, 1), a2 + hstep, voffA);
            PG8_WAIT_L(8); PG8_BAR; PG8_WAIT_L(0); PG8_MMA(0, 0, At, B0); PG8_BAR; PG8_SCHED;
            PG8_LDB(B1, 1, 1); PG8_STAGE(PG8_SB(1, 0), b3, voffB);
            PG8_BAR; PG8_WAIT_L(0); PG8_MMA(0, 1, At, B1); PG8_BAR;
            PG8_LDA(At, 1, 1); PG8_STAGE(PG8_SA(1, 0), a3, voffA);
            PG8_BAR; PG8_WAIT_L(0); PG8_MMA(1, 0, At, B0); PG8_BAR; PG8_SCHED;
            PG8_STAGE(PG8_SB(1, 1), b3 + hstep, voffB);
            PG8_WAIT_V(6); PG8_BAR; PG8_MMA(1, 1, At, B1); PG8_BAR;
            }
        }
        if constexpr (ALIGN_EPI) { if (wr == 0) PG8_BAR; }
        if constexpr (!Epi::AFTER_DRAIN) { E(acc, cur, wr, wc, fr, fq); S.done(cur); }
        if (!has_next) break;
#pragma unroll
        for (int a = 0; a < 2; ++a)
#pragma unroll
            for (int b = 0; b < 2; ++b)
#pragma unroll
                for (int m = 0; m < 4; ++m)
#pragma unroll
                    for (int n = 0; n < 2; ++n) acc[a][b][m][n] = (f32x4){0.f, 0.f, 0.f, 0.f};
        cur = nxt; cA = nA; cB = nB; ++ui;
        if constexpr (ALIGN_EPI) { if (wr == 1) PG8_BAR; }
    }
    PG8_WAIT_V(0);
    if constexpr (!ALIGN_EPI) { if (wr == 0) PG8_BAR; }
    PG8_BAR;
    if constexpr (Epi::AFTER_DRAIN) { E.fused(acc, cur, wr, wc, fr, fq, lds, wid, lane); S.done(cur); }
#undef PG8_SA
#undef PG8_SB
#undef PG8_STAGE
#undef PG8_LDA
#undef PG8_LDB
#undef PG8_MMA
#undef PG8_WAIT_V
#undef PG8_WAIT_L
#undef PG8_BAR
#undef PG8_SCHED
}
}

constexpr int DM = 2048, NB = 8, SEQ = 2048, NTOK = NB * SEQ, NDEC = 128;
constexpr int ROW_S = NTOK;
constexpr int ROWS_ACT = NTOK + 256;
constexpr int ROW_MEM = ROWS_ACT;
constexpr int A0_ROWS = ROWS_ACT + 2048;
constexpr int N0 = 4608, N1 = 7168;
constexpr float ALPHA = 1.41421356237f;
constexpr size_t O_YP = 0, O_YS = 33554432, O_MK = 33816576, O_MV = 35913728, O_SKP = 38010880, O_SVP = 38273024, O_HSP = 38535168, O_SKS = 40108032, O_SVS = 44302336, O_HSS = 48496640, O_END = 73662464;
constexpr size_t MiB = 1u << 20;
constexpr size_t WS_CTL = 0, WS_WT0 = 1 * MiB, WS_WT1 = 27 * MiB, WS_WO = 55 * MiB, WS_MKVB = 71 * MiB, WS_MISC = 79 * MiB, WS_R1 = 80 * MiB;
constexpr size_t WS_A0 = WS_R1, WS_U0 = WS_R1 + 73 * MiB, WS_U1 = WS_R1, WS_BR = 308 * MiB, WS_Z0 = 373 * MiB, WS_Z1 = 438 * MiB  , WS_H1 = 503 * MiB, WS_HG = 503 * MiB  , WS_END = 625 * MiB;
static_assert((size_t)A0_ROWS * DM * 2 <= 73 * MiB && WS_U0 + (size_t)ROWS_ACT * N0 * 2 <= WS_BR && WS_U1 + (size_t)ROWS_ACT * N1 * 2 <= WS_BR, "ws map");
static_assert(WS_BR + (size_t)ROWS_ACT * DM * 2 <= WS_Z0 && WS_Z0 + (size_t)ROWS_ACT * DM * 2 <= WS_Z1 && WS_Z1 + (size_t)ROWS_ACT * DM * 2 <= WS_H1 && WS_H1 + (size_t)ROWS_ACT * DM * 2 <= WS_END && WS_HG + (size_t)3072 * 41472 <= WS_END, "ws map");
constexpr int LDS_BYTES = 147456;

#define LAS __attribute__((address_space(3)))
typedef unsigned short bf16;
typedef unsigned v4u __attribute__((ext_vector_type(4)));
typedef unsigned v2u __attribute__((ext_vector_type(2)));
typedef float f32x4 __attribute__((ext_vector_type(4)));
typedef float f32x2 __attribute__((ext_vector_type(2)));
typedef short bf16x8 __attribute__((ext_vector_type(8)));
typedef short s16x4 __attribute__((ext_vector_type(4)));
typedef __bf16 bf16x2_t __attribute__((ext_vector_type(2)));
#define LDS_WAIT() asm volatile("s_waitcnt lgkmcnt(0)" ::: "memory")
#define LDS_BARRIER() do { asm volatile("s_waitcnt lgkmcnt(0)" ::: "memory"); __builtin_amdgcn_s_barrier(); asm volatile("" ::: "memory"); } while (0)

__device__ __forceinline__ float bf2f(unsigned short b) { return __uint_as_float((unsigned)b << 16); }
__device__ __forceinline__ unsigned pk2(float lo, float hi) { f32x2 v = {lo, hi}; bf16x2_t b = __builtin_convertvector(v, bf16x2_t); return __builtin_bit_cast(unsigned, b); }
__device__ __forceinline__ unsigned short f2bf(float f) { return (unsigned short)(pk2(f, 0.f) & 0xffffu); }
__device__ __forceinline__ float fast_rcp(float x) { return __builtin_amdgcn_rcpf(x); }
__device__ __forceinline__ float silu_f(float x) { return x * fast_rcp(1.f + __expf(-x)); }
__device__ __forceinline__ float sigmoid_f(float x) { return fast_rcp(1.f + __expf(-x)); }
__device__ __forceinline__ s16x4 vtr(const LAS unsigned char* p) { typedef short v4i16_t __attribute__((ext_vector_type(4))); return __builtin_bit_cast(s16x4, __builtin_amdgcn_ds_read_tr16_b64_v4i16((LAS v4i16_t*)p)); }
__device__ __forceinline__ float wave_sum(float v) {
#pragma unroll
    for (int o = 1; o < 64; o <<= 1) v += __shfl_xor(v, o);
    return v;
}
__device__ __forceinline__ float wave_max(float v) {
#pragma unroll
    for (int o = 1; o < 64; o <<= 1) v = fmaxf(v, __shfl_xor(v, o));
    return v;
}

__device__ __forceinline__ const unsigned char* uni_ptr(const void* p) { const unsigned long long v = (unsigned long long)p;
    const unsigned lo = __builtin_amdgcn_readfirstlane((unsigned)v), hi = __builtin_amdgcn_readfirstlane((unsigned)(v >> 32)); return (const unsigned char*)(((unsigned long long)hi << 32) | lo); }

struct Frame {
    LAS unsigned char* lds;
    int tid, lane, wave, G, bid;
    const float* in[19]; float* out; unsigned char* ws;
};

__device__ __forceinline__ void p0_transpose_item(const float* W, int K, int N, bf16* WT, int row_off, LAS float* scr, int item, int lane) {
    const int nblk = N / 32, kb = item / nblk, nb = item % nblk, k0 = 64 * kb, n0 = 32 * nb;
#pragma unroll 8
    for (int i = 0; i < 32; ++i) { const int kk = 2 * i + (lane >> 5); scr[kk * 33 + (lane & 31)] = __builtin_nontemporal_load(W + (size_t)(k0 + kk) * N + n0 + (lane & 31)); }
    LDS_WAIT(); asm volatile("" ::: "memory");
    const int c = lane & 7;
#pragma unroll
    for (int j = 0; j < 4; ++j) { const int n = (lane >> 3) + 8 * j; const LAS float* s = scr + (8 * c) * 33 + n;
        v4u o; o.x = pk2(s[0 * 33], s[1 * 33]); o.y = pk2(s[2 * 33], s[3 * 33]); o.z = pk2(s[4 * 33], s[5 * 33]); o.w = pk2(s[6 * 33], s[7 * 33]);
        *(v4u*)(WT + (size_t)(row_off + n0 + n) * K + k0 + 8 * c) = o; }
    LDS_WAIT(); asm volatile("" ::: "memory");
}
__device__ __forceinline__ void cvt_row(const float* src, bf16* dst, int lane) {
    const f32x4* s = (const f32x4*)src + lane; v2u* d = (v2u*)dst + lane;
#pragma unroll
    for (int j = 0; j < 8; ++j) { const f32x4 v = __builtin_nontemporal_load(s + 64 * j); v2u o; o.x = pk2(v.x, v.y); o.y = pk2(v.z, v.w); d[64 * j] = o; }
}
__device__ __forceinline__ void p0_prologue(Frame& F) {
    LAS float* scr = (LAS float*)(F.lds + F.wave * 16384);
    const int gw = F.bid * 8 + F.wave, NGW = F.G * 8;
    bf16* WT0 = (bf16*)(F.ws + WS_WT0); bf16* WT1 = (bf16*)(F.ws + WS_WT1); bf16* WO = (bf16*)(F.ws + WS_WO); bf16* A0 = (bf16*)(F.ws + WS_A0);
    constexpr int I_IN0 = 32 * (N0 / 32), I_MEM = 32 * 16, I_OUT = 32 * 64;
    constexpr int NITEMS = I_IN0 + 4 * I_MEM + 2 * I_OUT;
    for (int it = gw; it < NITEMS; it += NGW) {
        int r = it;
        if (r < I_IN0) { p0_transpose_item(F.in[9], DM, N0, WT0, 0, scr, r, F.lane); continue; } r -= I_IN0;
        if (r < 4 * I_MEM) { const int t = r / I_MEM; const float* w = (t < 2 ? F.in[14] : F.in[15]) + (size_t)(t & 1) * DM * 512;
            p0_transpose_item(w, DM, 512, WT0, N0 + 512 * t, scr, r % I_MEM, F.lane); continue; } r -= 4 * I_MEM;
        { const int l = r / I_OUT; p0_transpose_item(F.in[16] + (size_t)l * DM * DM, DM, DM, WO + (size_t)l * DM * DM, 0, scr, r % I_OUT, F.lane); }
    }
    for (int m = gw; m < A0_ROWS; m += NGW) {
        bf16* dst = A0 + (size_t)m * DM;
        if (m < NTOK) cvt_row(F.in[0] + (size_t)m * DM, dst, F.lane);
        else if (m < NTOK + NDEC) cvt_row(F.in[1] + (size_t)(m - NTOK) * DM, dst, F.lane);
        else if (m < ROW_MEM) { v4u z = {0u, 0u, 0u, 0u}; v4u* d = (v4u*)dst + F.lane;
#pragma unroll
            for (int j = 0; j < 4; ++j) d[64 * j] = z; }
        else cvt_row(F.in[7] + (size_t)(m - ROW_MEM) * DM, dst, F.lane);
    }
}

__device__ __forceinline__ void p1_convert_wt1(Frame& F, int span) {
    if (span > F.G) span = F.G;
    const int first = F.G - 1 - F.bid; if (first >= span) return;
    LAS float* scr = (LAS float*)(F.lds + F.wave * 16384); bf16* WT1 = (bf16*)(F.ws + WS_WT1);
    __syncthreads();
    for (int it = first * 8 + F.wave; it < 32 * (N1 / 32); it += span * 8) p0_transpose_item(F.in[11], DM, N1, WT1, 0, scr, it, F.lane);
    __syncthreads();
}

__device__ __forceinline__ void ln_row(const bf16* z, const float* w, const float* bb, bf16* obf, float* of32, float* st, int lane) {
    const v4u* zr = (const v4u*)z + lane; float v[32]; float s = 0.f;
#pragma unroll
    for (int j = 0; j < 4; ++j) { const v4u q = __builtin_nontemporal_load(zr + 64 * j);
        v[8 * j + 0] = __uint_as_float(q.x << 16); v[8 * j + 1] = __uint_as_float(q.x & 0xffff0000u); v[8 * j + 2] = __uint_as_float(q.y << 16); v[8 * j + 3] = __uint_as_float(q.y & 0xffff0000u);
        v[8 * j + 4] = __uint_as_float(q.z << 16); v[8 * j + 5] = __uint_as_float(q.z & 0xffff0000u); v[8 * j + 6] = __uint_as_float(q.w << 16); v[8 * j + 7] = __uint_as_float(q.w & 0xffff0000u);
#pragma unroll
        for (int i = 0; i < 8; ++i) s += v[8 * j + i]; }
    const float mean = wave_sum(s) * (1.f / DM); float s2 = 0.f;
#pragma unroll
    for (int i = 0; i < 32; ++i) { v[i] -= mean; s2 += v[i] * v[i]; }
    const float rstd = 1.f / sqrtf(wave_sum(s2) * (1.f / DM) + 1e-5f);
    if (st && lane == 0) { st[0] = mean; st[1] = rstd; }
#pragma unroll
    for (int j = 0; j < 4; ++j) { const int e0 = (lane + 64 * j) * 8; const f32x4 w0 = *(const f32x4*)(w + e0), w1 = *(const f32x4*)(w + e0 + 4), b0 = *(const f32x4*)(bb + e0), b1 = *(const f32x4*)(bb + e0 + 4);
        const f32x4 y0 = (f32x4){v[8 * j], v[8 * j + 1], v[8 * j + 2], v[8 * j + 3]} * rstd * w0 + b0, y1 = (f32x4){v[8 * j + 4], v[8 * j + 5], v[8 * j + 6], v[8 * j + 7]} * rstd * w1 + b1;
        if (of32) { __builtin_nontemporal_store(y0, (f32x4*)(of32 + e0)); __builtin_nontemporal_store(y1, (f32x4*)(of32 + e0 + 4)); }
        if (obf) { v4u o; o.x = pk2(y0.x, y0.y); o.y = pk2(y0.z, y0.w); o.z = pk2(y1.x, y1.y); o.w = pk2(y1.z, y1.w); *(v4u*)(obf + e0) = o; } }
}

__device__ __forceinline__ void build_bias_tab(Frame& F, LAS float* tab) {
    const float* rb = F.in[8];
    for (int i = F.tid; i < 24 * 128; i += 512) { const int h = i >> 7, d = i & 127; int bk;
        if (d < 16) bk = d; else { bk = 16 + (int)(logf((float)d / 16.f) / 2.0794415416798357f * 16.f); bk = bk < 31 ? bk : 31; }
        tab[i] = rb[bk * 24 + h]; }
}
constexpr int SWA_TABR = 131072, TABR_LD = 160;
__device__ __forceinline__ void build_bias_tabr(Frame& F, const LAS float* tab, LAS float* tabr) {
    for (int i = F.tid; i < 24 * TABR_LD; i += 512) { const int h = i / TABR_LD, x = i % TABR_LD, d = 16 + 127 - x; tabr[i] = (d >= 0 && d < 128) ? tab[h * 128 + d] * 1.4426950408889634f : 0.f; }
}
constexpr int SWA_ROWS = 400, SWA_KS = 0, SWA_VS = SWA_ROWS * 144, SWA_TAB = 2 * SWA_ROWS * 144;
static_assert(SWA_TAB + 24 * 128 * 4 <= SWA_TABR, "SWA LDS map");
__device__ __forceinline__ void swa_prompt_unit(Frame& F, int b, int kvh, int qb4) {
    const bf16* U0 = (const bf16*)(F.ws + WS_U0); bf16* BR = (bf16*)(F.ws + WS_BR);
    LAS unsigned char* Ks = F.lds + SWA_KS; LAS unsigned char* Vs = F.lds + SWA_VS; const LAS float* tabr = (const LAS float*)(F.lds + SWA_TABR);
    const int q00 = qb4 * 256, lane = F.lane, fr = lane & 15, fq = lane >> 4;
    __syncthreads();
    { v4u tb[13];
#pragma unroll
      for (int i = 0; i < 13; ++i) { const int id = F.tid + 512 * i, which = id >= SWA_ROWS * 8, rem = id - which * (SWA_ROWS * 8), r = rem >> 3, ch = rem & 7; const int kp = q00 - 128 + r;
          tb[i] = (v4u){0u, 0u, 0u, 0u};
          if (id < 2 * SWA_ROWS * 8 && r < 384 && kp >= 0) tb[i] = *(const v4u*)(U0 + (size_t)(b * SEQ + kp) * N0 + 1536 + which * 256 + kvh * 64 + ch * 8); }
#pragma unroll
      for (int i = 0; i < 13; ++i) { const int id = F.tid + 512 * i, which = id >= SWA_ROWS * 8, rem = id - which * (SWA_ROWS * 8), r = rem >> 3, ch = rem & 7;
          if (id < 2 * SWA_ROWS * 8) *(LAS v4u*)((which ? Vs : Ks) + r * 144 + ch * 16) = tb[i]; } }
    __syncthreads();
    const float* sinks = F.in[10];
#pragma unroll 1
    for (int su = 0; su < 4; ++su) {
    const int q0 = q00 + 64 * su; LAS unsigned char* Ksu = Ks + su * 64 * 144; LAS unsigned char* Vsu = Vs + su * 64 * 144;
    bf16x8 qf[3][2]; v2u gv[3][4];
#pragma unroll
    for (int j = 0; j < 3; ++j) { const int gi = F.wave * 3 + j, head = kvh * 6 + (gi >> 2); const size_t qrow = (size_t)(b * SEQ + q0 + (gi & 3) * 16 + fr);
#pragma unroll
        for (int ks = 0; ks < 2; ++ks) qf[j][ks] = __builtin_nontemporal_load((const bf16x8*)(U0 + qrow * N0 + head * 64 + ks * 32 + fq * 8));
#pragma unroll
        for (int dt = 0; dt < 4; ++dt) gv[j][dt] = __builtin_nontemporal_load((const v2u*)(U0 + qrow * N0 + 2560 + head * 64 + 16 * dt + 4 * fq)); }
#pragma unroll
    for (int j = 0; j < 3; ++j) {
        const int gi = F.wave * 3 + j, g = gi >> 2, qsub = gi & 3, head = kvh * 6 + g, qs = q0 + qsub * 16;
        const size_t qrow = (size_t)(b * SEQ + qs + fr);
        f32x4 sacc[9];
#pragma unroll
        for (int T3 = 0; T3 < 3; ++T3) { bf16x8 kf[3][2];
#pragma unroll
            for (int t = 0; t < 3; ++t)
#pragma unroll
                for (int ks = 0; ks < 2; ++ks) kf[t][ks] = *(const LAS bf16x8*)(Ksu + (qsub * 16 + 16 * (3 * T3 + t) + fr) * 144 + (ks * 32 + fq * 8) * 2);
            __builtin_amdgcn_sched_barrier(0);
#pragma unroll
            for (int t = 0; t < 3; ++t) { f32x4 a = {0.f, 0.f, 0.f, 0.f};
#pragma unroll
                for (int ks = 0; ks < 2; ++ks) a = __builtin_amdgcn_mfma_f32_16x16x32_bf16(kf[t][ks], qf[j][ks], a, 0, 0, 0);
                sacc[3 * T3 + t] = a; }
            __builtin_amdgcn_sched_barrier(0); }
        const float L2E = 1.4426950408889634f; const float sink2 = sinks[head] * L2E; float mx = sink2;
        const LAS float* tb = tabr + head * TABR_LD + 15 - fr + 4 * fq; const int kmin = 128 - qs;
#pragma unroll
        for (int T = 0; T < 9; ++T) {
#pragma unroll
            for (int r = 0; r < 4; ++r) { float s = __builtin_fmaf(sacc[T][r], 0.125f * L2E, tb[16 * T + r]);
                if (T == 0) s = (4 * fq + r > fr) ? s : -INFINITY;
                if (T == 8) s = (4 * fq + r <= fr) ? s : -INFINITY;
                sacc[T][r] = s; }
            if (16 * T < kmin) sacc[T] = (f32x4){-INFINITY, -INFINITY, -INFINITY, -INFINITY};
            mx = fmaxf(mx, fmaxf(fmaxf(sacc[T][0], sacc[T][1]), fmaxf(sacc[T][2], sacc[T][3]))); }
        mx = fmaxf(mx, __shfl_xor(mx, 16)); mx = fmaxf(mx, __shfl_xor(mx, 32));
        float sum = 0.f;
#pragma unroll
        for (int T = 0; T < 9; ++T)
#pragma unroll
            for (int r = 0; r < 4; ++r) { const float p = __builtin_amdgcn_exp2f(sacc[T][r] - mx); sacc[T][r] = p; sum += p; }
        sum += __shfl_xor(sum, 16); sum += __shfl_xor(sum, 32);
        const float inv = 1.f / (sum + __builtin_amdgcn_exp2f(sink2 - mx));
        bf16x8 pf[5];
#pragma unroll
        for (int mm = 0; mm < 5; ++mm) { v4u w; w.x = pk2(sacc[2 * mm][0], sacc[2 * mm][1]); w.y = pk2(sacc[2 * mm][2], sacc[2 * mm][3]);
            if (mm < 4) { w.z = pk2(sacc[2 * mm + 1][0], sacc[2 * mm + 1][1]); w.w = pk2(sacc[2 * mm + 1][2], sacc[2 * mm + 1][3]); } else { w.z = 0u; w.w = 0u; }
            pf[mm] = __builtin_bit_cast(bf16x8, w); }
        f32x4 oacc[4];
#pragma unroll
        for (int d2 = 0; d2 < 2; ++d2) { s16x4 vlo[2][5], vhi[2][5];
#pragma unroll
            for (int t = 0; t < 2; ++t)
#pragma unroll
                for (int mm = 0; mm < 5; ++mm) { const LAS unsigned char* vp = Vsu + (qsub * 16 + 32 * mm + 4 * fq + (fr >> 2)) * 144 + (16 * (2 * d2 + t) + 4 * (fr & 3)) * 2; vlo[t][mm] = vtr(vp); vhi[t][mm] = vtr(vp + 16 * 144); }
            __builtin_amdgcn_sched_barrier(0);
#pragma unroll
            for (int t = 0; t < 2; ++t) { f32x4 a = {0.f, 0.f, 0.f, 0.f};
#pragma unroll
                for (int mm = 0; mm < 5; ++mm) { const bf16x8 vf = (bf16x8){vlo[t][mm][0], vlo[t][mm][1], vlo[t][mm][2], vlo[t][mm][3], vhi[t][mm][0], vhi[t][mm][1], vhi[t][mm][2], vhi[t][mm][3]};
                    a = __builtin_amdgcn_mfma_f32_16x16x32_bf16(vf, pf[mm], a, 0, 0, 0); }
                oacc[2 * d2 + t] = a; }
            __builtin_amdgcn_sched_barrier(0); }
#pragma unroll
        for (int dt = 0; dt < 4; ++dt) { const int col = head * 64 + 16 * dt + 4 * fq; const v2u g2 = gv[j][dt];
            const float g0 = bf2f((unsigned short)(g2.x & 0xffff)), g1 = bf2f((unsigned short)(g2.x >> 16)), g2f = bf2f((unsigned short)(g2.y & 0xffff)), g3 = bf2f((unsigned short)(g2.y >> 16));
            v2u o; o.x = pk2(oacc[dt][0] * inv * silu_f(g0), oacc[dt][1] * inv * silu_f(g1)); o.y = pk2(oacc[dt][2] * inv * silu_f(g2f), oacc[dt][3] * inv * silu_f(g3));
            *(v2u*)(BR + qrow * DM + col) = o; }
        asm volatile("" ::: "memory");
    }
    }
}

constexpr int MEM_KS = 0, MEM_VS = 256 * 272, MEM_VST = 288;
__device__ __forceinline__ void mem_prompt_unit(Frame& F, int layer, int b, int h, int qblk, const bf16* U, int ldu, int mq_col0, int gate_col0, int vflags = 0) {
    const bf16* MK = (const bf16*)(F.ws + WS_MKVB) + (size_t)layer * (2048 * 512); const bf16* MV = MK + (size_t)2 * (2048 * 512);
    bf16* BR = (bf16*)(F.ws + WS_BR);
    LAS unsigned char* Ks = F.lds + MEM_KS; LAS unsigned char* Vs = F.lds + MEM_VS;
    const int lane = F.lane, fr = lane & 15, fq = lane >> 4;
    bf16x8 qfa[2][4];
#pragma unroll
    for (int j = 0; j < 2; ++j) { const size_t qrow = (size_t)(b * SEQ + qblk * 256 + (F.wave * 2 + j) * 16 + fr);
#pragma unroll
        for (int ks = 0; ks < 4; ++ks) qfa[j][ks] = __builtin_nontemporal_load((const bf16x8*)(U + qrow * ldu + mq_col0 + h * 128 + ks * 32 + fq * 8)); }
    __syncthreads();
    if (!(vflags & 1024)) { v4u tb[16];
#pragma unroll
      for (int i = 0; i < 16; ++i) { const int id = F.tid + 512 * i, which = i >> 3, rem = id & 4095, r = rem >> 4, ch = rem & 15;
          tb[i] = *(const v4u*)((which ? MV : MK) + (size_t)(b * 256 + r) * 512 + h * 128 + ch * 8); }
#pragma unroll
      for (int i = 0; i < 16; ++i) { const int id = F.tid + 512 * i, which = i >> 3, rem = id & 4095, r = rem >> 4, ch = rem & 15;
          *(LAS v4u*)((which ? Vs + r * MEM_VST : Ks + r * 272) + ch * 16) = tb[i]; } }
    __syncthreads();
    const float cexp = 0.08838834764831845f * 1.4426950408889634f;
    if (vflags & 2048) return;
#define SB() __builtin_amdgcn_sched_barrier(0)
#pragma unroll
    for (int j = 0; j < 2; ++j) {
        const int qs = qblk * 256 + (F.wave * 2 + j) * 16; const size_t qrow = (size_t)(b * SEQ + qs + fr);
        v2u gva[8];
#pragma unroll
        for (int dt = 0; dt < 8; ++dt) gva[dt] = __builtin_nontemporal_load((const v2u*)(U + qrow * ldu + gate_col0 + 1536 + h * 128 + 16 * dt + 4 * fq));
        f32x4 sacc[16]; float mx = -INFINITY;
#pragma unroll
        for (int T2 = 0; T2 < 8; ++T2) { bf16x8 kf[2][4];
            if (vflags & 4096) { sacc[2 * T2] = (f32x4){0.f, 1.f, 2.f, 3.f}; sacc[2 * T2 + 1] = (f32x4){1.f, 0.f, 3.f, 2.f}; continue; }
#pragma unroll
            for (int t = 0; t < 2; ++t)
#pragma unroll
                for (int ks = 0; ks < 4; ++ks) kf[t][ks] = *(const LAS bf16x8*)(Ks + (16 * (2 * T2 + t) + fr) * 272 + (ks * 32 + fq * 8) * 2);
            SB();
#pragma unroll
            for (int t = 0; t < 2; ++t) { f32x4 a = {0.f, 0.f, 0.f, 0.f};
#pragma unroll
                for (int ks = 0; ks < 4; ++ks) a = __builtin_amdgcn_mfma_f32_16x16x32_bf16(kf[t][ks], qfa[j][ks], a, 0, 0, 0);
                sacc[2 * T2 + t] = a; }
            SB(); }
#pragma unroll
        for (int T = 0; T < 16; ++T) mx = fmaxf(mx, fmaxf(fmaxf(sacc[T][0], sacc[T][1]), fmaxf(sacc[T][2], sacc[T][3])));
        mx = fmaxf(mx, __shfl_xor(mx, 16)); mx = fmaxf(mx, __shfl_xor(mx, 32));
        const float nmx = -mx * cexp; float sum = 0.f; bf16x8 pf[8];
#pragma unroll
        for (int mm = 0; mm < 8; ++mm) { float p[8];
#pragma unroll
            for (int r = 0; r < 4; ++r) { if (vflags & 8192) { p[r] = sacc[2 * mm][r]; p[4 + r] = sacc[2 * mm + 1][r]; } else { p[r] = __builtin_amdgcn_exp2f(__builtin_fmaf(sacc[2 * mm][r], cexp, nmx)); p[4 + r] = __builtin_amdgcn_exp2f(__builtin_fmaf(sacc[2 * mm + 1][r], cexp, nmx)); } sum += p[r] + p[4 + r]; }
            v4u w; w.x = pk2(p[0], p[1]); w.y = pk2(p[2], p[3]); w.z = pk2(p[4], p[5]); w.w = pk2(p[6], p[7]); pf[mm] = __builtin_bit_cast(bf16x8, w); }
        sum += __shfl_xor(sum, 16); sum += __shfl_xor(sum, 32);
        const float inv = 1.f / sum;
#pragma unroll
        for (int d2 = 0; d2 < 4; ++d2) { s16x4 vlo[2][8], vhi[2][8];
            if (vflags & 16384) continue;
#pragma unroll
            for (int t = 0; t < 2; ++t)
#pragma unroll
                for (int mm = 0; mm < 8; ++mm) { const LAS unsigned char* vp = Vs + (32 * mm + 4 * fq + (fr >> 2)) * MEM_VST + (16 * (2 * d2 + t) + 4 * (fr & 3)) * 2; vlo[t][mm] = vtr(vp); vhi[t][mm] = vtr(vp + 16 * MEM_VST); }
            SB();
            f32x4 oacc[2];
#pragma unroll
            for (int t = 0; t < 2; ++t) { oacc[t] = (f32x4){0.f, 0.f, 0.f, 0.f};
#pragma unroll
                for (int mm = 0; mm < 8; ++mm) { const bf16x8 vf = (bf16x8){vlo[t][mm][0], vlo[t][mm][1], vlo[t][mm][2], vlo[t][mm][3], vhi[t][mm][0], vhi[t][mm][1], vhi[t][mm][2], vhi[t][mm][3]};
                    oacc[t] = __builtin_amdgcn_mfma_f32_16x16x32_bf16(vf, pf[mm], oacc[t], 0, 0, 0); } }
            SB();
#pragma unroll
            for (int t = 0; t < 2; ++t) { const int dt = 2 * d2 + t, col = h * 128 + 16 * dt + 4 * fq; const v2u gv = gva[dt];
                const float g0 = __uint_as_float(gv.x << 16), g1 = __uint_as_float(gv.x & 0xffff0000u), g2 = __uint_as_float(gv.y << 16), g3 = __uint_as_float(gv.y & 0xffff0000u);
                v2u o; o.x = pk2(oacc[t][0] * inv * silu_f(g0), oacc[t][1] * inv * silu_f(g1)); o.y = pk2(oacc[t][2] * inv * silu_f(g2), oacc[t][3] * inv * silu_f(g3));
                *(v2u*)(BR + qrow * DM + 1536 + col) = o; } }
    }
#undef SB
}

__device__ __forceinline__ void swa_sample_unit(Frame& F, int b, const LAS float* tab) {
    const bf16* U0 = (const bf16*)(F.ws + WS_U0); bf16* BR = (bf16*)(F.ws + WS_BR);
    LAS float* red = (LAS float*)(F.lds);
    LAS float* qf = (LAS float*)(F.lds + 73728);
    LAS float* kn = qf + 1536;
    LAS float* vn = kn + 256;
    LAS float* sc = vn + 256;
    LAS float* pinv = sc + 24 * 128;
    const size_t row = (size_t)(ROW_S + b);
    const float* ck = F.in[4] + (size_t)b * 128 * 256; const float* cv = F.in[5] + (size_t)b * 128 * 256;
    float* ok = F.out + O_SKS + (size_t)b * 128 * 256; float* ov = F.out + O_SVS + (size_t)b * 128 * 256;
    __syncthreads();
    for (int i = F.tid; i < 2048; i += 512) { const float v = bf2f(U0[row * N0 + i]); if (i < 1536) qf[i] = v; else if (i < 1792) kn[i - 1536] = v; else vn[i - 1792] = v; }
    __syncthreads();
    { const int j = F.tid >> 2, kvh = F.tid & 3; f32x4 kr[16];
#pragma unroll
      for (int c4 = 0; c4 < 16; ++c4) { if (j < 127) kr[c4] = __builtin_nontemporal_load((const f32x4*)(ck + (j + 1) * 256 + kvh * 64 + c4 * 4)); else kr[c4] = *(const LAS f32x4*)(kn + kvh * 64 + c4 * 4); }
      float acc[6] = {0.f, 0.f, 0.f, 0.f, 0.f, 0.f};
#pragma unroll
      for (int c4 = 0; c4 < 16; ++c4) { __builtin_nontemporal_store(kr[c4], (f32x4*)(ok + j * 256 + kvh * 64 + c4 * 4));
#pragma unroll
          for (int g = 0; g < 6; ++g) { const f32x4 q = *(const LAS f32x4*)(qf + (kvh * 6 + g) * 64 + c4 * 4); acc[g] += kr[c4].x * q.x + kr[c4].y * q.y + kr[c4].z * q.z + kr[c4].w * q.w; } }
#pragma unroll
      for (int g = 0; g < 6; ++g) { const int head = kvh * 6 + g; sc[head * 128 + j] = acc[g] * 0.125f + tab[head * 128 + (127 - j)]; } }
    const int vkvh = F.tid >> 7, jq = (F.tid >> 4) & 7, d4 = F.tid & 15; f32x4 vr[16];
#pragma unroll
    for (int i = 0; i < 16; ++i) { const int j = jq * 16 + i; if (j < 127) vr[i] = __builtin_nontemporal_load((const f32x4*)(cv + (j + 1) * 256 + vkvh * 64 + d4 * 4)); else vr[i] = *(const LAS f32x4*)(vn + vkvh * 64 + d4 * 4); }
    __syncthreads();
    for (int hh = 0; hh < 3; ++hh) { const int head = F.wave * 3 + hh; const float sink = F.in[10][head];
        const float s0 = sc[head * 128 + F.lane], s1 = sc[head * 128 + 64 + F.lane];
        const float mx = fmaxf(wave_max(fmaxf(s0, s1)), sink); const float p0 = __expf(s0 - mx), p1 = __expf(s1 - mx);
        const float sum = wave_sum(p0 + p1); sc[head * 128 + F.lane] = p0; sc[head * 128 + 64 + F.lane] = p1;
        if (F.lane == 0) pinv[head] = 1.f / (sum + __expf(sink - mx)); }
    __syncthreads();
    { f32x4 oa[6];
#pragma unroll
      for (int g = 0; g < 6; ++g) oa[g] = (f32x4){0.f, 0.f, 0.f, 0.f};
#pragma unroll
      for (int i = 0; i < 16; ++i) { const int j = jq * 16 + i; __builtin_nontemporal_store(vr[i], (f32x4*)(ov + j * 256 + vkvh * 64 + d4 * 4));
#pragma unroll
          for (int g = 0; g < 6; ++g) oa[g] += vr[i] * sc[(vkvh * 6 + g) * 128 + j]; }
#pragma unroll
      for (int g = 0; g < 6; ++g) *(LAS f32x4*)(red + (jq * 24 + vkvh * 6 + g) * 64 + d4 * 4) = oa[g]; }
    __syncthreads();
    for (int i = F.tid; i < 1536; i += 512) { const int head = i >> 6, d = i & 63; float o = 0.f;
#pragma unroll
        for (int q8 = 0; q8 < 8; ++q8) o += red[(q8 * 24 + head) * 64 + d];
        const float g = bf2f(U0[row * N0 + 2560 + i]);
        BR[row * DM + i] = f2bf(o * pinv[head] * silu_f(g)); }
}
__device__ __forceinline__ void mem_sample_unit(Frame& F, int layer, int b, int h, const bf16* U, int ldu, int mq_col0, int gate_col0) {
    bf16* BR = (bf16*)(F.ws + WS_BR);
    LAS float* sc = (LAS float*)(F.lds + 73728 + 32768);
    LAS float* red = sc + 256;
    const size_t row = (size_t)(ROW_S + b);
    const float* mk = F.in[2] + ((size_t)layer * NDEC + b) * (256 * 512) + h * 128; const float* mv = F.in[3] + ((size_t)layer * NDEC + b) * (256 * 512) + h * 128;
    const int half = F.lane >> 5, l32 = F.lane & 31, w = F.wave;
    const v2u qraw = *(const v2u*)(U + row * ldu + mq_col0 + h * 128 + l32 * 4);
    unsigned short graw = 0; if (F.tid < 128) graw = U[row * ldu + gate_col0 + 1536 + h * 128 + F.tid];
    f32x4 kv[16];
#pragma unroll
    for (int i = 0; i < 16; ++i) kv[i] = __builtin_nontemporal_load((const f32x4*)(mk + (size_t)(32 * w + 2 * i + half) * 512 + l32 * 4));
    __syncthreads();
    { const float sc0 = 0.08838834764831845f;
      const f32x4 qq = (f32x4){__uint_as_float(qraw.x << 16), __uint_as_float(qraw.x & 0xffff0000u), __uint_as_float(qraw.y << 16), __uint_as_float(qraw.y & 0xffff0000u)} * sc0;
#pragma unroll
      for (int i = 0; i < 16; ++i) { float p = kv[i].x * qq.x + kv[i].y * qq.y + kv[i].z * qq.z + kv[i].w * qq.w;
          p += __shfl_xor(p, 1); p += __shfl_xor(p, 2); p += __shfl_xor(p, 4); p += __shfl_xor(p, 8); p += __shfl_xor(p, 16);
          if (l32 == 0) sc[32 * w + 2 * i + half] = p; } }
    f32x4 vv[16];
#pragma unroll
    for (int i = 0; i < 16; ++i) vv[i] = __builtin_nontemporal_load((const f32x4*)(mv + (size_t)(32 * w + 2 * i + half) * 512 + l32 * 4));
    __syncthreads();
    if (w == 0) { float s[4]; float mx = -INFINITY;
#pragma unroll
        for (int i = 0; i < 4; ++i) { s[i] = sc[64 * i + F.lane]; mx = fmaxf(mx, s[i]); }
        mx = wave_max(mx); float sum = 0.f;
#pragma unroll
        for (int i = 0; i < 4; ++i) { s[i] = __expf(s[i] - mx); sum += s[i]; }
        sum = wave_sum(sum); const float inv = 1.f / sum;
#pragma unroll
        for (int i = 0; i < 4; ++i) sc[64 * i + F.lane] = s[i] * inv; }
    __syncthreads();
    { f32x4 o4 = {0.f, 0.f, 0.f, 0.f};
#pragma unroll
      for (int i = 0; i < 16; ++i) o4 += vv[i] * sc[32 * w + 2 * i + half];
      o4.x += __shfl_xor(o4.x, 32); o4.y += __shfl_xor(o4.y, 32); o4.z += __shfl_xor(o4.z, 32); o4.w += __shfl_xor(o4.w, 32);
      if (half == 0) *(LAS f32x4*)(red + w * 128 + l32 * 4) = o4; }
    __syncthreads();
    if (F.tid < 128) { float o = 0.f;
#pragma unroll
        for (int i = 0; i < 8; ++i) o += red[i * 128 + F.tid];
        BR[row * DM + 1536 + h * 128 + F.tid] = f2bf(o * silu_f(bf2f(graw))); }
}
__device__ __forceinline__ void hgrn_sample_unit(Frame& F, int b, int h) {
    const bf16* U1 = (const bf16*)(F.ws + WS_U1); bf16* BR = (bf16*)(F.ws + WS_BR);
    LAS float* qs = (LAS float*)(F.lds + 73728 + 49152);
    LAS float* fk = qs + 128; LAS float* kk = fk + 128; LAS float* vv = kk + 128; LAS float* red = vv + 128;
    LAS float* tot = red + 2048;
    const size_t row = (size_t)(ROW_S + b);
    const float* S0 = F.in[6] + ((size_t)b * 12 + h) * 16384; float* So = F.out + O_HSS + ((size_t)b * 12 + h) * 16384;
    const int c4 = F.tid & 31, kr = F.tid >> 5;
    f32x4 s4[8];
#pragma unroll
    for (int i = 0; i < 8; ++i) s4[i] = __builtin_nontemporal_load((const f32x4*)(S0 + (kr + 16 * i) * 128 + c4 * 4));
    unsigned short graw = 0, qraw = 0, fraw = 0, vraw = 0;
    if (F.tid < 128) { graw = U1[row * N1 + 5120 + h * 128 + F.tid]; qraw = U1[row * N1 + h * 128 + F.tid]; fraw = U1[row * N1 + 1536 + h * 128 + F.tid]; }
    else if (F.tid < 256) vraw = U1[row * N1 + 3072 + h * 128 + F.tid - 128];
    __syncthreads();
    if (F.tid < 128) { const int k = F.tid; const float l0 = F.in[12][h * 128 + k], l1 = F.in[12][1536 + h * 128 + k]; const float lb = fast_rcp(1.f + __expf(l0 - l1));
        const float fg = lb + (1.f - lb) * sigmoid_f(bf2f(fraw)); qs[k] = silu_f(bf2f(qraw)); fk[k] = fg; kk[k] = 1.f - fg; }
    else if (F.tid < 256) vv[F.tid - 128] = bf2f(vraw);
    __syncthreads();
    { const f32x4 v4 = *(const LAS f32x4*)(vv + c4 * 4); f32x4 o4 = {0.f, 0.f, 0.f, 0.f};
#pragma unroll
      for (int i = 0; i < 8; ++i) { const int k = kr + 16 * i; const f32x4 sn = s4[i] * fk[k] + v4 * kk[k];
          __builtin_nontemporal_store(sn, (f32x4*)(So + k * 128 + c4 * 4)); o4 += sn * qs[k]; }
      *(LAS f32x4*)(red + kr * 128 + c4 * 4) = o4; }
    __syncthreads();
    float o = 0.f;
    if (F.tid < 128) {
#pragma unroll
        for (int i = 0; i < 16; ++i) o += red[i * 128 + F.tid];
        const float ss = wave_sum(o * o); if (F.lane == 0) tot[F.wave] = ss; }
    __syncthreads();
    if (F.tid < 128) { const float rstd = 1.f / sqrtf((tot[0] + tot[1]) * (1.f / 128.f) + 1e-6f); const int c = h * 128 + F.tid;
        BR[row * DM + c] = f2bf(o * rstd * F.in[13][c] * silu_f(bf2f(graw))); }
}

constexpr int HG_REC = 41472, HGR_QG = 0, HGR_KDT = 16384, HGR_AS = 32768, HGR_EGL = 40960;
constexpr int HG_QG = 0, HG_QT = 17408, HG_KT = 34816, HG_VS = 52224, HG_KDT = 69632, HG_AS = 88064, HG_SEG = 97280, HG_EGL = 99328, HG_PART = 99840;
__device__ __forceinline__ float row16_sum(float v) {
    int x = __builtin_bit_cast(int, v);
    v += __builtin_bit_cast(float, __builtin_amdgcn_update_dpp(0, x, 0xB1, 0xF, 0xF, false)); x = __builtin_bit_cast(int, v);
    v += __builtin_bit_cast(float, __builtin_amdgcn_update_dpp(0, x, 0x4E, 0xF, 0xF, false)); x = __builtin_bit_cast(int, v);
    v += __builtin_bit_cast(float, __builtin_amdgcn_update_dpp(0, x, 0x141, 0xF, 0xF, false)); x = __builtin_bit_cast(int, v);
    v += __builtin_bit_cast(float, __builtin_amdgcn_update_dpp(0, x, 0x140, 0xF, 0xF, false));
    return v;
}
__device__ __forceinline__ void hgrn_prep_phase(Frame& F) {
    const bf16* U1 = (const bf16*)(F.ws + WS_U1); unsigned char* HG = F.ws + WS_HG;
    LAS unsigned char* L = F.lds; LAS float* SEG = (LAS float*)(L + HG_SEG);
    const int tid = F.tid, lane = F.lane, w = F.wave, fr = lane & 15, fq = lane >> 4;
    const int k = tid & 127, tq = tid >> 7;
    const float L2E = 1.4426950408889634f;
    unsigned short nqr[16], nfr[16];
#define HGP_LOAD(id_) do { const int bh_ = (id_) >> 5, c_ = (id_) & 31, b_ = bh_ / 12, h_ = bh_ % 12; const size_t r0_ = (size_t)b_ * SEQ + c_ * 64 + tq * 16; \
        _Pragma("unroll") for (int i = 0; i < 16; ++i) { nqr[i] = __builtin_nontemporal_load(U1 + (r0_ + i) * N1 + h_ * 128 + k); nfr[i] = __builtin_nontemporal_load(U1 + (r0_ + i) * N1 + 1536 + h_ * 128 + k); } } while (0)
    int id = F.bid;
    if (id < NB * 12 * 32) HGP_LOAD(id);
    __syncthreads();
#pragma unroll 1
    for (; id < NB * 12 * 32; id += F.G) {
        const int bh = id >> 5, h = bh % 12;
        unsigned char* rec = HG + (size_t)id * HG_REC;
        float lbk; { const float l0 = F.in[12][h * 128 + k], l1 = F.in[12][1536 + h * 128 + k]; lbk = fast_rcp(1.f + __expf(l0 - l1)); }
        const float oml = 1.f - lbk;
        float gl[16], qv[16], kv[16]; float run = 0.f;
#pragma unroll
        for (int i = 0; i < 16; ++i) { const float f = bf2f(nfr[i]), q = bf2f(nqr[i]);
            const float sg = fast_rcp(1.f + __builtin_amdgcn_exp2f(-L2E * f)); const float fg = __builtin_fmaf(sg, oml, lbk);
            run += __builtin_amdgcn_logf(fg); gl[i] = run; kv[i] = 1.f - fg; qv[i] = q * fast_rcp(1.f + __builtin_amdgcn_exp2f(-L2E * q)); }
        SEG[tq * 128 + k] = run;
        if (id + F.G < NB * 12 * 32) HGP_LOAD(id + F.G);
        LDS_BARRIER();
        const float s0 = SEG[k], s1 = SEG[128 + k], s2 = SEG[256 + k], s3 = SEG[384 + k];
        const float gmid = s0 + s1, glast = gmid + s2 + s3;
        const float basem = ((tq == 0) ? 0.f : (tq == 1) ? s0 : (tq == 2) ? gmid : gmid + s2) - gmid;
        const float egm = __builtin_amdgcn_exp2f(gmid), eglm = __builtin_amdgcn_exp2f(glast - gmid);
        if (tq == 0) *(float*)(rec + HGR_EGL + 4 * k) = __builtin_amdgcn_exp2f(glast);
        { unsigned kd[8];
#pragma unroll
          for (int i = 0; i < 16; ++i) { const int t = tq * 16 + i; const float x = __builtin_amdgcn_fmed3f(basem + gl[i], -115.f, 115.f);
              const float e1 = __builtin_amdgcn_exp2f(x), e2 = fast_rcp(e1); const float qt = qv[i] * e1, kt = kv[i] * e2;
              const unsigned pq = pk2(qt, qt * egm);
              *(LAS unsigned short*)(L + HG_QT + t * 272 + k * 2) = (unsigned short)(pq & 0xffffu);
              *(LAS unsigned short*)(L + HG_QG + t * 272 + k * 2) = (unsigned short)(pq >> 16);
              const unsigned pkk = pk2(kt, kt * eglm);
              *(LAS unsigned short*)(L + HG_KT + t * 272 + k * 2) = (unsigned short)(pkk & 0xffffu);
              if (i & 1) kd[i >> 1] |= (pkk & 0xffff0000u); else kd[i >> 1] = pkk >> 16; }
          *(LAS v4u*)(L + HG_KDT + k * 144 + tq * 32) = (v4u){kd[0], kd[1], kd[2], kd[3]};
          *(LAS v4u*)(L + HG_KDT + k * 144 + tq * 32 + 16) = (v4u){kd[4], kd[5], kd[6], kd[7]}; }
        LDS_BARRIER();
#pragma unroll
        for (int jj = 0; jj < 2; ++jj) { const int tile = 2 * w + jj, tt = tile >> 2, ts = tile & 3; f32x4 a = {0.f, 0.f, 0.f, 0.f};
            if (ts <= tt) {
#pragma unroll
                for (int ks = 0; ks < 4; ++ks) { const bf16x8 af = *(const LAS bf16x8*)(L + HG_QT + (16 * tt + fr) * 272 + (32 * ks + 8 * fq) * 2);
                    const bf16x8 bfv = *(const LAS bf16x8*)(L + HG_KT + (16 * ts + fr) * 272 + (32 * ks + 8 * fq) * 2);
                    a = __builtin_amdgcn_mfma_f32_16x16x32_bf16(af, bfv, a, 0, 0, 0); } }
#pragma unroll
            for (int r = 0; r < 4; ++r) { const int t = 16 * tt + 4 * fq + r, s = 16 * ts + fr; const float v = (ts <= tt && s <= t) ? a[r] : 0.f;
                *(LAS unsigned short*)(L + HG_AS + t * 144 + s * 2) = f2bf(v); } }
        LDS_BARRIER();
#pragma unroll
        for (int i = 0; i < 2; ++i) { const int p = tid + 512 * i; *(v4u*)(rec + HGR_QG + p * 16) = *(const LAS v4u*)(L + HG_QG + (p >> 4) * 272 + (p & 15) * 16); }
#pragma unroll
        for (int i = 0; i < 2; ++i) { const int p = tid + 512 * i; *(v4u*)(rec + HGR_KDT + p * 16) = *(const LAS v4u*)(L + HG_KDT + (p >> 3) * 144 + (p & 7) * 16); }
        { const int p = tid; *(v4u*)(rec + HGR_AS + p * 16) = *(const LAS v4u*)(L + HG_AS + (p >> 3) * 144 + (p & 7) * 16); }
        LDS_BARRIER();
    }
#undef HGP_LOAD
}
constexpr int HG_GT = 101888;
struct HgStage { v4u st[9]; f32x4 egl; };
__device__ __forceinline__ void hgs_load(HgStage& S, const unsigned char* HG, const bf16* U1, int b, int h, int cc, int tid) {
    typedef const __attribute__((address_space(1))) unsigned char* gp;
    gp rec = (gp)(HG + (size_t)cc * HG_REC); gp vb = (gp)(U1 + ((size_t)b * SEQ + cc * 64) * N1 + 3072 + h * 128);
    const unsigned o16 = (unsigned)tid * 16u, ov = ((unsigned)(tid >> 4) * N1 + (unsigned)(tid & 15) * 8u) * 2u;
    typedef const __attribute__((address_space(1))) v4u* g4; typedef const __attribute__((address_space(1))) f32x4* gf4;
    S.st[0] = __builtin_nontemporal_load((g4)(rec + HGR_QG + o16)); S.st[1] = __builtin_nontemporal_load((g4)(rec + HGR_QG + 8192 + o16));
    S.st[2] = __builtin_nontemporal_load((g4)(rec + HGR_KDT + o16)); S.st[3] = __builtin_nontemporal_load((g4)(rec + HGR_KDT + 8192 + o16));
    S.st[4] = __builtin_nontemporal_load((g4)(rec + HGR_AS + o16));
    S.st[5] = __builtin_nontemporal_load((g4)(vb + ov)); S.st[6] = __builtin_nontemporal_load((g4)(vb + (size_t)32 * N1 * 2 + ov));
    S.st[7] = __builtin_nontemporal_load((g4)(vb + 2048 * 2 + ov)); S.st[8] = __builtin_nontemporal_load((g4)(vb + (size_t)32 * N1 * 2 + 2048 * 2 + ov));
    if (tid < 32) S.egl = *(gf4)(rec + HGR_EGL + o16);
}
__device__ __forceinline__ void hgs_stage(const HgStage& S, LAS unsigned char* L, int tid) {
    const int r = tid >> 4, ch = tid & 15, r8 = tid >> 3, c8 = tid & 7;
    *(LAS v4u*)(L + HG_QG + r * 272 + ch * 16) = S.st[0]; *(LAS v4u*)(L + HG_QG + (32 + r) * 272 + ch * 16) = S.st[1];
    *(LAS v4u*)(L + HG_KDT + r8 * 144 + c8 * 16) = S.st[2]; *(LAS v4u*)(L + HG_KDT + (64 + r8) * 144 + c8 * 16) = S.st[3];
    *(LAS v4u*)(L + HG_AS + r8 * 144 + c8 * 16) = S.st[4];
    *(LAS v4u*)(L + HG_VS + r * 272 + ch * 16) = S.st[5]; *(LAS v4u*)(L + HG_VS + (32 + r) * 272 + ch * 16) = S.st[6];
    *(LAS v4u*)(L + HG_GT + r * 272 + ch * 16) = S.st[7]; *(LAS v4u*)(L + HG_GT + (32 + r) * 272 + ch * 16) = S.st[8];
    if (tid < 32) *(LAS f32x4*)(L + HG_EGL + tid * 16) = S.egl;
}
constexpr int HG_RSTD = 119296;
constexpr int HG_PART2 = 119552;
__device__ __forceinline__ void hgs_compute(f32x4 (&Sacc)[8], LAS unsigned char* L, v2u (&pend)[4], const f32x4 nw4, int tid, int w, int fr, int fq) {
    LAS float* EGL = (LAS float*)(L + HG_EGL); LAS float* PART = (LAS float*)(L + HG_PART2); LAS float* RSTD = (LAS float*)(L + HG_RSTD); const int dv0 = 16 * w;
#define SB() __builtin_amdgcn_sched_barrier(0)
    bf16x8 vf[2]; f32x4 o[4];
    { bf16x8 as[4][2];
#pragma unroll
      for (int ks = 0; ks < 2; ++ks) { const LAS unsigned char* vp = L + HG_VS + (32 * ks + 8 * fq + (fr >> 2)) * 272 + (dv0 + 4 * (fr & 3)) * 2;
          const s16x4 lo = vtr(vp), hi = vtr(vp + 4 * 272); vf[ks] = (bf16x8){lo[0], lo[1], lo[2], lo[3], hi[0], hi[1], hi[2], hi[3]}; }
#pragma unroll
      for (int tt = 0; tt < 4; ++tt)
#pragma unroll
          for (int ks = 0; ks < 2; ++ks) as[tt][ks] = *(const LAS bf16x8*)(L + HG_AS + (16 * tt + fr) * 144 + (32 * ks + 8 * fq) * 2);
      SB();
#pragma unroll
      for (int tt = 0; tt < 4; ++tt) { o[tt] = (f32x4){0.f, 0.f, 0.f, 0.f};
#pragma unroll
          for (int ks = 0; ks < 2; ++ks) o[tt] = __builtin_amdgcn_mfma_f32_16x16x32_bf16(vf[ks], as[tt][ks], o[tt], 0, 0, 0); }
      SB(); }
    bf16x8 sb[4];
#pragma unroll
    for (int mm = 0; mm < 4; ++mm) { v4u wv; wv.x = pk2(Sacc[2 * mm][0], Sacc[2 * mm][1]); wv.y = pk2(Sacc[2 * mm][2], Sacc[2 * mm][3]);
        wv.z = pk2(Sacc[2 * mm + 1][0], Sacc[2 * mm + 1][1]); wv.w = pk2(Sacc[2 * mm + 1][2], Sacc[2 * mm + 1][3]); sb[mm] = __builtin_bit_cast(bf16x8, wv); }
#pragma unroll
    for (int hh = 0; hh < 2; ++hh) { v2u qa[2][4][2];
#pragma unroll
        for (int t2 = 0; t2 < 2; ++t2)
#pragma unroll
            for (int mm = 0; mm < 4; ++mm) { const LAS unsigned char* qp = L + HG_QG + (16 * (2 * hh + t2) + fr) * 272 + (32 * mm + 4 * fq) * 2; qa[t2][mm][0] = *(const LAS v2u*)qp; qa[t2][mm][1] = *(const LAS v2u*)(qp + 32); }
        SB();
#pragma unroll
        for (int t2 = 0; t2 < 2; ++t2)
#pragma unroll
            for (int mm = 0; mm < 4; ++mm) o[2 * hh + t2] = __builtin_amdgcn_mfma_f32_16x16x32_bf16(sb[mm], __builtin_bit_cast(bf16x8, (v4u){qa[t2][mm][0].x, qa[t2][mm][0].y, qa[t2][mm][1].x, qa[t2][mm][1].y}), o[2 * hh + t2], 0, 0, 0);
        SB(); }
#pragma unroll
    for (int hh = 0; hh < 2; ++hh) { bf16x8 ka[4][2]; f32x4 ega[4];
#pragma unroll
        for (int T = 0; T < 4; ++T) { ega[T] = *(const LAS f32x4*)(EGL + 16 * (4 * hh + T) + 4 * fq);
#pragma unroll
            for (int ks = 0; ks < 2; ++ks) ka[T][ks] = *(const LAS bf16x8*)(L + HG_KDT + (16 * (4 * hh + T) + fr) * 144 + (32 * ks + 8 * fq) * 2); }
        SB();
#pragma unroll
        for (int T = 0; T < 4; ++T) { f32x4 acc = Sacc[4 * hh + T] * ega[T];
#pragma unroll
            for (int ks = 0; ks < 2; ++ks) acc = __builtin_amdgcn_mfma_f32_16x16x32_bf16(ka[T][ks], vf[ks], acc, 0, 0, 0);
            Sacc[4 * hh + T] = acc; }
        SB(); }
#undef SB
#pragma unroll
    for (int tt = 0; tt < 4; ++tt) { const f32x4 q = o[tt] * o[tt]; PART[(16 * tt + fr) * 32 + 4 * w + fq] = (q.x + q.y) + (q.z + q.w); }
    LDS_BARRIER();
    { const int t = tid >> 3, j = tid & 7; const f32x4 p = *(const LAS f32x4*)(PART + t * 32 + 4 * j); float s = (p.x + p.y) + (p.z + p.w);
      int x = __builtin_bit_cast(int, s);
      s += __builtin_bit_cast(float, __builtin_amdgcn_update_dpp(0, x, 0xB1, 0xF, 0xF, false)); x = __builtin_bit_cast(int, s);
      s += __builtin_bit_cast(float, __builtin_amdgcn_update_dpp(0, x, 0x4E, 0xF, 0xF, false)); x = __builtin_bit_cast(int, s);
      s += __builtin_bit_cast(float, __builtin_amdgcn_update_dpp(0, x, 0x141, 0xF, 0xF, false));
      if (j == 0) RSTD[t] = __builtin_amdgcn_rsqf(s * (1.f / 128.f) + 1e-6f); }
    LDS_BARRIER();
#pragma unroll
    for (int tt = 0; tt < 4; ++tt) { const int t = 16 * tt + fr; const float rstd = RSTD[t]; const v2u g2 = *(const LAS v2u*)(L + HG_GT + t * 272 + (dv0 + 4 * fq) * 2);
        const float g0 = __uint_as_float(g2.x << 16), g1 = __uint_as_float(g2.x & 0xffff0000u), g2f = __uint_as_float(g2.y << 16), g3 = __uint_as_float(g2.y & 0xffff0000u);
        const f32x4 y = o[tt] * rstd * nw4;
        pend[tt].x = pk2(y.x * silu_f(g0), y.y * silu_f(g1)); pend[tt].y = pk2(y.z * silu_f(g2f), y.w * silu_f(g3)); }
    LDS_BARRIER();
}
__device__ __forceinline__ void hgrn_seq_unit(Frame& F, int b, int h, int vflags) {
    const bf16* U1 = (const bf16*)(F.ws + WS_U1); bf16* BR = (bf16*)(F.ws + WS_BR); const unsigned char* HG = F.ws + WS_HG + (size_t)(b * 12 + h) * 32 * HG_REC;
    LAS unsigned char* L = F.lds;
    const int tid = F.tid, lane = F.lane, w = F.wave, fr = lane & 15, fq = lane >> 4;
    const f32x4 nw4 = *(const f32x4*)(F.in[13] + h * 128 + 16 * w + 4 * fq);
    f32x4 Sacc[8];
#pragma unroll
    for (int T = 0; T < 8; ++T) Sacc[T] = (f32x4){0.f, 0.f, 0.f, 0.f};
    HgStage SA, SB; SA.egl = SB.egl = (f32x4){0.f, 0.f, 0.f, 0.f};
    v2u pend[4];
#pragma unroll
    for (int i = 0; i < 4; ++i) pend[i] = (v2u){0u, 0u};
    hgs_load(SA, HG, U1, b, h, 0, tid); hgs_load(SB, HG, U1, b, h, 1, tid);
    __syncthreads();
#define HGS_STORE(cc) do { bf16* op_ = BR + ((size_t)b * SEQ + (cc) * 64 + fr) * DM + h * 128 + 16 * w + 4 * fq; \
        _Pragma("unroll") for (int tt = 0; tt < 4; ++tt) *(v2u*)(op_ + (size_t)(16 * tt) * DM) = pend[tt]; } while (0)
#define HGS_STEP(S, cc) do { if (!(vflags & 512)) hgs_stage(S, L, tid); asm volatile("" ::: "memory"); \
        if ((cc) > 0 && !(vflags & 128)) HGS_STORE((cc) - 1); asm volatile("" ::: "memory"); \
        if ((cc) + 2 < 32 && !(vflags & 64)) hgs_load(S, HG, U1, b, h, (cc) + 2, tid); \
        LDS_BARRIER(); if (!(vflags & 256)) hgs_compute(Sacc, L, pend, nw4, tid, w, fr, fq); } while (0)
#pragma unroll 1
    for (int c = 0; c < 32; c += 2) { HGS_STEP(SA, c); HGS_STEP(SB, c + 1); }
#undef HGS_STEP
    HGS_STORE(31);
#undef HGS_STORE
    float* So = F.out + O_HSP + ((size_t)b * 12 + h) * 16384;
#pragma unroll
    for (int T = 0; T < 8; ++T)
#pragma unroll
        for (int r = 0; r < 4; ++r) __builtin_nontemporal_store(Sacc[T][r], So + (16 * T + 4 * fq + r) * 128 + 16 * w + fr);
}

struct SkStoreProj { bf16* U; int ldu;
    __device__ __forceinline__ void operator()(int row, int col, f32x4 v) const { v2u o; o.x = pk2(v.x, v.y); o.y = pk2(v.z, v.w); *(v2u*)(U + (size_t)(ROW_S + row) * ldu + col) = o; } };
struct SkStoreOut { bf16* Z; int mode; const bf16* xb; const bf16* zprev; const float* stats; const float* lnw; const float* lnb;
    __device__ __forceinline__ void operator()(int row, int col, f32x4 v) const { const size_t ro = (size_t)(ROW_S + row) * DM + col; const v2u q = *(const v2u*)((mode == 0 ? xb : zprev) + ro);
        f32x4 r = (f32x4){__uint_as_float(q.x << 16), __uint_as_float(q.x & 0xffff0000u), __uint_as_float(q.y << 16), __uint_as_float(q.y & 0xffff0000u)};
        if (mode == 1) { const float mu = stats[2 * (ROW_S + row)], rs = stats[2 * (ROW_S + row) + 1]; r = (r - mu) * rs * *(const f32x4*)(lnw + col) + *(const f32x4*)(lnb + col); }
        const f32x4 y = r * ALPHA + v; v2u o; o.x = pk2(y.x, y.y); o.y = pk2(y.z, y.w); *(v2u*)(Z + ro) = o; } };
template <class Store>
__device__ __forceinline__ void skinny_unit(Frame& F, const bf16* A, const bf16* Bt, int n0, const Store& st) {
    const int lane = F.lane, fr = lane & 15, fq = lane >> 4, w = F.wave;
    f32x4 acc[8][2];
#pragma unroll
    for (int m = 0; m < 8; ++m) { acc[m][0] = (f32x4){0.f, 0.f, 0.f, 0.f}; acc[m][1] = (f32x4){0.f, 0.f, 0.f, 0.f}; }
    const bf16* ap = A + (size_t)fr * DM + 256 * w + 8 * fq; const bf16* bp = Bt + (size_t)(n0 + fr) * DM + 256 * w + 8 * fq;
#pragma unroll 4
    for (int ks = 0; ks < 8; ++ks) { bf16x8 bfr[2], afr[8];
#pragma unroll
        for (int n = 0; n < 2; ++n) bfr[n] = *(const bf16x8*)(bp + (size_t)n * 16 * DM + ks * 32);
#pragma unroll
        for (int m = 0; m < 8; ++m) afr[m] = *(const bf16x8*)(ap + (size_t)m * 16 * DM + ks * 32);
#pragma unroll
        for (int m = 0; m < 8; ++m)
#pragma unroll
            for (int n = 0; n < 2; ++n) acc[m][n] = __builtin_amdgcn_mfma_f32_16x16x32_bf16(bfr[n], afr[m], acc[m][n], 0, 0, 0); }
    LAS f32x4* red = (LAS f32x4*)F.lds;
    __syncthreads();
#pragma unroll
    for (int m = 0; m < 8; ++m)
#pragma unroll
        for (int n = 0; n < 2; ++n) red[(w * 16 + m * 2 + n) * 64 + lane] = acc[m][n];
    __syncthreads();
#pragma unroll
    for (int n = 0; n < 2; ++n) { f32x4 s = {0.f, 0.f, 0.f, 0.f};
#pragma unroll
        for (int ww = 0; ww < 8; ++ww) s += red[(ww * 16 + w * 2 + n) * 64 + lane];
        st(16 * w + fr, n0 + 16 * n + 4 * fq, s); }
}
template <class Store>
__device__ __forceinline__ void skinny_phase(Frame& F, const bf16* A, const bf16* Bt, int N, int span, const Store& st) {
    if (span > F.G) span = F.G;
    const int first = F.G - 1 - F.bid; if (first >= span) return;
    for (int u = first; u < N / 32; u += span) skinny_unit(F, A, Bt, 32 * u, st);
}

#define XB_TMO      128
#define XB_XCNT(j)  (256  + 64 * (j))
#define XB_XSUB(j)  (1280 + 64 * (j))
#define XB_XGEN(j)  (2304 + 64 * (j))
#define XB_TOP      3328
#define XB_TOPGEN   3392
#define XCD_BAR_WORDS 3456
#define XB_SPIN_CAP (1u << 18)

__device__ __forceinline__ unsigned xb_ld(unsigned* p)              { return __hip_atomic_load(p, __ATOMIC_RELAXED, __HIP_MEMORY_SCOPE_AGENT); }
__device__ __forceinline__ unsigned xb_add(unsigned* p, unsigned v) { return __hip_atomic_fetch_add(p, v, __ATOMIC_RELAXED, __HIP_MEMORY_SCOPE_AGENT); }
__device__ __forceinline__ unsigned xb_xcc_id() { return (unsigned)__builtin_amdgcn_s_getreg((3 << 11) | 20) & 0xFu; }
#define XB_SPIN(cond, bar) do { unsigned _sp = 0; while (cond) { __builtin_amdgcn_s_sleep(1); \
    if ((++_sp & 255u) == 0u) { if (xb_ld(&(bar)[XB_TMO])) break; if (_sp > XB_SPIN_CAP) { atomicAdd(&(bar)[XB_TMO], 1u); break; } } } } while (0)

struct XcdBarrier {
    unsigned* bar; unsigned x;
    volatile LAS unsigned* st;
};

__device__ __forceinline__ XcdBarrier xcd_barrier_post(unsigned* bar, volatile LAS unsigned* st) {
    XcdBarrier b; b.bar = bar; b.x = xb_xcc_id(); b.st = st;
    if (threadIdx.x == 0) (void)xb_add(&bar[XB_XCNT(b.x)], 1u);
    return b;
}
__device__ __forceinline__ void xcd_barrier_complete(unsigned* bar, unsigned x, unsigned& nloc, unsigned& nx) {
    const unsigned G = gridDim.x * gridDim.y * gridDim.z;
    unsigned sum, cnt, mine, sp = 0u;
    for (;;) {
        sum = 0u; cnt = 0u; mine = 0u;
#pragma unroll
        for (unsigned j = 0; j < 16; ++j) { const unsigned c = xb_ld(&bar[XB_XCNT(j)]); sum += c; cnt += (c > 0u) ? 1u : 0u; mine = (j == x) ? c : mine; }
        if (sum == G) break;
        __builtin_amdgcn_s_sleep(1);
        if ((++sp & 255u) == 0u) { if (xb_ld(&bar[XB_TMO])) break; if (sp > XB_SPIN_CAP) { atomicAdd(&bar[XB_TMO], 1u); break; } }
    }
    nloc = mine > 0u ? mine : 1u; nx = cnt > 0u ? cnt : 1u;
}

__device__ __forceinline__ void xcd_barrier(const XcdBarrier& b) {
    asm volatile("s_waitcnt vmcnt(0)" ::: "memory");
    __syncthreads();
    if (threadIdx.x == 0) {
        unsigned* bar = b.bar;
        __builtin_amdgcn_s_waitcnt(0);
        unsigned nloc = b.st[0], nx = b.st[1];
        if (nloc == 0u) { xcd_barrier_complete(bar, b.x, nloc, nx); b.st[0] = nloc; b.st[1] = nx; }
        const unsigned old = xb_add(&bar[XB_XSUB(b.x)], 1u);
        const unsigned gen = old / nloc;
        if (old + 1u == (gen + 1u) * nloc) {
            __builtin_amdgcn_fence(__ATOMIC_RELEASE, "agent");
            asm volatile("s_waitcnt vmcnt(0)" ::: "memory");
            const unsigned og = xb_add(&bar[XB_TOP], 1u);
            const unsigned tg = og / nx;
            if (og + 1u == (tg + 1u) * nx) xb_add(&bar[XB_TOPGEN], 1u);
            else XB_SPIN(xb_ld(&bar[XB_TOPGEN]) == tg, bar);
            __builtin_amdgcn_fence(__ATOMIC_ACQUIRE, "agent");
            xb_add(&bar[XB_XGEN(b.x)], 1u);
            asm volatile("s_waitcnt vmcnt(0)" ::: "memory");
        } else {
            XB_SPIN(xb_ld(&bar[XB_XGEN(b.x)]) == gen, bar);
            __builtin_amdgcn_fence(__ATOMIC_ACQUIRE, "agent");
            asm volatile("s_waitcnt vmcnt(0)" ::: "memory");
        }
    }
    __syncthreads();
}

constexpr int LDS_MISC = LDS_BYTES - 256;
constexpr size_t CTL_ZERO_BYTES = 262144;
struct Args { const float* in[19]; float* out; unsigned char* ws; int ph_lo, ph_hi, li, flags; };
constexpr int N_PHASES = 10;
#ifndef MK_PLAN
#define MK_PLAN 0
#endif

__global__ void __launch_bounds__(512, 2) fwd_megakernel(Args args) {
    extern __shared__ __attribute__((aligned(16))) unsigned char lds_raw[];
    Frame F;
    F.lds = (LAS unsigned char*)lds_raw;
    F.tid = threadIdx.x; F.lane = F.tid & 63; F.wave = __builtin_amdgcn_readfirstlane(F.tid >> 6);
    F.G = gridDim.x; F.bid = blockIdx.x;
#pragma unroll
    for (int i = 0; i < 19; ++i) F.in[i] = args.in[i];
    F.out = args.out; F.ws = args.ws;
    const int lo = args.ph_lo, hi = args.ph_hi, fl = args.flags;
    if (F.tid < 64) ((LAS unsigned*)(F.lds + LDS_MISC))[F.tid] = 0u;
    __syncthreads();
    XcdBarrier bar = xcd_barrier_post((unsigned*)(F.ws + WS_CTL) + 1024 + args.li * 4096, (volatile LAS unsigned*)(F.lds + LDS_MISC));
#define IN(k) (lo <= (k) && (k) < hi)
#define SEAM(k) do { if (IN(k) && IN((k) + 1)) { xcd_barrier(bar); } } while (0)
    const int gw = F.bid * 8 + F.wave, NGW = F.G * 8;
    bf16* A0 = (bf16*)(F.ws + WS_A0); bf16* U0 = (bf16*)(F.ws + WS_U0); bf16* U1 = (bf16*)(F.ws + WS_U1); bf16* BR = (bf16*)(F.ws + WS_BR);
    bf16* H1 = (bf16*)(F.ws + WS_H1); bf16* Z0 = (bf16*)(F.ws + WS_Z0); bf16* Z1 = (bf16*)(F.ws + WS_Z1); float* STATS = (float*)(F.ws + WS_MISC);
    bf16* WT0 = (bf16*)(F.ws + WS_WT0); bf16* WT1 = (bf16*)(F.ws + WS_WT1); bf16* WO = (bf16*)(F.ws + WS_WO); bf16* MKVB = (bf16*)(F.ws + WS_MKVB);

    if (IN(0)) { p0_prologue(F); }
    SEAM(0);
    if (IN(1)) {
        pg8::Gemm g{A0, WT0, A0_ROWS, N0 + 2048, DM};
        pg8::OrderExt S; S.init(NTOK, N0, F.G, F.bid, 64, ROWS_ACT / 256, N0 / 256, 8);
        pg8::EpiProj E{U0, N0, N0 / 256, ROWS_ACT / 256, F.out + O_MK, MKVB};
        pg8::gemm_phase<pg8::EpiProj, pg8::OrderExt, true, true>(F.lds, g, S, E);
        skinny_phase(F, A0 + (size_t)ROW_S * DM, WT0, N0, 64, SkStoreProj{U0, N0});
        p1_convert_wt1(F, 64);
    }
    SEAM(1);
    if (IN(2)) {
        LAS float* tab = (LAS float*)(F.lds + SWA_TAB);
        __syncthreads(); build_bias_tab(F, tab); __syncthreads(); build_bias_tabr(F, tab, (LAS float*)(F.lds + SWA_TABR)); __syncthreads();
        if (!(fl & 4)) for (int id = F.bid; id < 256; id += F.G) { const int b = id >> 5, rem = id & 31; swa_prompt_unit(F, b, rem >> 3, rem & 7); }
        if (!(fl & 16)) for (int b = F.bid; b < NDEC; b += F.G) swa_sample_unit(F, b, tab);
        if (!(fl & 8)) for (int id = F.bid; id < 256; id += F.G) { const int b = id >> 5, rem = id & 31; mem_prompt_unit(F, 0, b, rem >> 3, rem & 7, U0, N0, 2048, 2560, fl); }
        if (!(fl & 32)) {
            if (F.G == 256) { if (F.bid < 128) mem_sample_unit(F, 0, F.bid >> 2, F.bid & 3, U0, N0, 2048, 2560);
                else for (int k3 = 0; k3 < 3; ++k3) { const int u = 128 + (F.bid - 128) * 3 + k3; mem_sample_unit(F, 0, u >> 2, u & 3, U0, N0, 2048, 2560); } }
            else for (int u = F.G - 1 - F.bid; u < NDEC * 4; u += F.G) mem_sample_unit(F, 0, u >> 2, u & 3, U0, N0, 2048, 2560); }
        for (int i = F.bid * 512 + F.tid; i < NB * 128 * 512; i += F.G * 512) { const int b = i >> 16, r = (i >> 9) & 127, c = i & 511;
            const float v = bf2f(U0[(size_t)(b * SEQ + SEQ - 128 + r) * N0 + 1536 + c]);
            if (c < 256) F.out[O_SKP + (size_t)(b * 128 + r) * 256 + c] = v; else F.out[O_SVP + (size_t)(b * 128 + r) * 256 + (c - 256)] = v; }
    }
    SEAM(2);
    if (IN(3)) {
        pg8::Gemm g{BR, WO, ROWS_ACT, DM, DM};
        pg8::OrderExt S; S.init(NTOK, DM, F.G, F.bid, 0, 0, 0, 1);
        pg8::EpiOut E{Z0, 0, A0, Z0, STATS, F.in[17], F.in[18], ALPHA};
        pg8::gemm_phase<pg8::EpiOut, pg8::OrderExt, true, true>(F.lds, g, S, E);
        skinny_phase(F, BR + (size_t)ROW_S * DM, WO, DM, 256, SkStoreOut{Z0, 0, A0, Z0, STATS, F.in[17], F.in[18]});
    }
    SEAM(3);
    if (IN(4)) { for (int m = gw; m < NTOK + NDEC; m += NGW) ln_row(Z0 + (size_t)m * DM, F.in[17], F.in[18], H1 + (size_t)m * DM, nullptr, STATS + 2 * m, F.lane); }
    SEAM(4);
    if (IN(5)) {
        pg8::Gemm g{H1, WT1, ROWS_ACT, N1, DM};
        pg8::OrderExt S; S.init(NTOK, N1, F.G, F.bid, 0, 0, 0, 1);
        pg8::EpiProj E{U1, N1, N1 / 256, 0, F.out + O_MK, MKVB};
        pg8::gemm_phase<pg8::EpiProj, pg8::OrderExt, true, true>(F.lds, g, S, E);
        skinny_phase(F, H1 + (size_t)ROW_S * DM, WT1, N1, 256, SkStoreProj{U1, N1});
    }
    SEAM(5);
    if (IN(6)) {
        if (!(fl & 1)) hgrn_prep_phase(F);
    }
    SEAM(6);
    if (IN(7)) {
        const int nH = 96;
        if (F.G > nH) {
            if (F.bid < nH) { if (!(fl & 1)) hgrn_seq_unit(F, F.bid / 12, F.bid % 12, fl); }
            else if (!(fl & 2)) { const int nO = F.G - nH;
                for (int it = F.bid - nH; it < 256 + 512; it += nO) {
                    if (it < 256) { const int b = it >> 5, rem = it & 31; mem_prompt_unit(F, 1, b, rem >> 3, rem & 7, U1, N1, 4608, 5120); }
                    else mem_sample_unit(F, 1, (it - 256) >> 2, (it - 256) & 3, U1, N1, 4608, 5120); }
                for (int u = F.G - 1 - F.bid; u < NDEC * 12; u += nO) hgrn_sample_unit(F, u / 12, u % 12); }
        } else {
            for (int u = F.bid; u < nH; u += F.G) hgrn_seq_unit(F, u / 12, u % 12, fl);
            for (int it = F.bid; it < 256 + 512; it += F.G) {
                if (it < 256) { const int b = it >> 5, rem = it & 31; mem_prompt_unit(F, 1, b, rem >> 3, rem & 7, U1, N1, 4608, 5120); }
                else mem_sample_unit(F, 1, (it - 256) >> 2, (it - 256) & 3, U1, N1, 4608, 5120); }
            for (int u = F.bid; u < NDEC * 12; u += F.G) hgrn_sample_unit(F, u / 12, u % 12);
        }
    }
    SEAM(7);
    if (IN(8)) {
        pg8::Gemm g{BR, WO + (size_t)DM * DM, ROWS_ACT, DM, DM};
        pg8::OrderExt S; S.init(NTOK, DM, F.G, F.bid, 0, 0, 0, 1);
        pg8::EpiOut E{Z1, 1, A0, Z0, STATS, F.in[17], F.in[18], ALPHA};
        pg8::gemm_phase<pg8::EpiOut, pg8::OrderExt, true, true>(F.lds, g, S, E);
        skinny_phase(F, BR + (size_t)ROW_S * DM, WO + (size_t)DM * DM, DM, 256, SkStoreOut{Z1, 1, A0, Z0, STATS, F.in[17], F.in[18]});
    }
    SEAM(8);
    if (IN(9)) { for (int m = gw; m < NTOK + NDEC; m += NGW) ln_row(Z1 + (size_t)m * DM, F.in[17] + DM, F.in[18] + DM, nullptr, F.out + (size_t)m * DM, nullptr, F.lane); }
#undef IN
#undef SEAM
}

extern "C" void kernel_launch(void* const* d_in, const int* in_sizes, int n_in, void* d_out, int out_size, void* d_ws, size_t ws_size, hipStream_t stream) {
    static int grid = 0;
    if (grid == 0) {
        if (n_in != 19 || (size_t)out_size != O_END || ws_size < WS_END) { fprintf(stderr, "kernel_launch: unexpected shapes: n_in %d out %d ws %zu (need %zu)\n", n_in, out_size, ws_size, (size_t)WS_END); grid = -1; return; }
        int dev = 0, cus = 0, per_cu = 0;
        if (hipGetDevice(&dev) != hipSuccess || hipDeviceGetAttribute(&cus, hipDeviceAttributeMultiprocessorCount, dev) != hipSuccess) { grid = -1; return; }
        if (hipFuncSetAttribute((const void*)fwd_megakernel, hipFuncAttributeMaxDynamicSharedMemorySize, LDS_BYTES) != hipSuccess) { fprintf(stderr, "kernel_launch: hipFuncSetAttribute failed\n"); grid = -1; return; }
        if (hipOccupancyMaxActiveBlocksPerMultiprocessor(&per_cu, (const void*)fwd_megakernel, 512, LDS_BYTES) != hipSuccess || per_cu < 1) { fprintf(stderr, "kernel_launch: occupancy query failed (%d)\n", per_cu); (void)hipGetLastError(); per_cu = 1; }
        grid = cus * (per_cu < 1 ? 1 : 1);
        fprintf(stderr, "kernel_launch: grid %d (cus %d, per_cu %d)\n", grid, cus, per_cu);
    }
    if (grid < 0) return;
    if (hipMemsetAsync((char*)d_ws + WS_CTL, 0, CTL_ZERO_BYTES, stream) != hipSuccess) { fprintf(stderr, "kernel_launch: memset failed\n"); return; }
    Args a{};
    for (int i = 0; i < 19; ++i) a.in[i] = (const float*)d_in[i];
    a.out = (float*)d_out; a.ws = (unsigned char*)d_ws;
#if MK_PLAN == 0
    const int plan[][3] = {{0, N_PHASES, 0}};
#elif MK_PLAN == 1
    const int plan[][3] = {{0, 3, 0}, {2, 3, 0}, {3, 8, 0}, {6, 8, 0}, {8, N_PHASES, 0}};
#elif MK_PLAN == 2
    const int plan[][3] = {{0, 1, 0}, {0, 5, 0}, {4, N_PHASES, 0}};
#elif MK_PLAN == 3
    const int plan[][3] = {{0, 3, 0}, {3, 8, 0}, {6, 8, 0}, {8, N_PHASES, 0}};
#elif MK_PLAN == 4
    const int plan[][3] = {{0, 3, 0}, {2, 3, 0}, {3, N_PHASES, 0}};
#elif MK_PLAN == 5
    const int plan[][3] = {{0, 3, 0}, {3, 8, 0}, {8, N_PHASES, 0}};
#elif MK_PLAN == 6
    const int plan[][3] = {{0, 3, 0}, {3, 7, 0}, {6, 7, 0}, {7, N_PHASES, 0}};
#elif MK_PLAN == 7
    const int plan[][3] = {{0, 3, 0}, {3, 8, 0}, {7, 8, 0}, {8, N_PHASES, 0}};
#elif MK_PLAN == 8
    const int plan[][3] = {{0, 3, 0}, {2, 3, 8 + 16 + 32}, {3, N_PHASES, 0}};
#elif MK_PLAN == 9
    const int plan[][3] = {{0, 3, 0}, {2, 3, 4 + 16 + 32}, {3, N_PHASES, 0}};
#elif MK_PLAN == 11
    const int plan[][3] = {{0, 3, 0}, {3, 8, 0}, {7, 8, 2}, {8, N_PHASES, 0}};
#elif MK_PLAN == 12
    const int plan[][3] = {{0, 3, 0}, {3, 8, 0}, {7, 8, 1}, {8, N_PHASES, 0}};
#elif MK_PLAN == 13
    const int plan[][3] = {{0, 7, 0}, {7, 8, 2 + 64}, {7, 8, 0}, {8, N_PHASES, 0}};
#elif MK_PLAN == 14
    const int plan[][3] = {{0, 7, 0}, {7, 8, 2 + 128}, {7, 8, 0}, {8, N_PHASES, 0}};
#elif MK_PLAN == 15
    const int plan[][3] = {{0, 7, 0}, {7, 8, 2}, {7, 8, 0}, {8, N_PHASES, 0}};
#elif MK_PLAN == 16
    const int plan[][3] = {{0, 7, 0}, {7, 8, 2 + 64 + 256}, {7, 8, 0}, {8, N_PHASES, 0}};
#elif MK_PLAN == 17
    const int plan[][3] = {{0, 7, 0}, {7, 8, 2 + 64 + 128 + 512}, {7, 8, 0}, {8, N_PHASES, 0}};
#elif MK_PLAN == 18
    const int plan[][3] = {{0, 2, 0}, {1, 2, 0}, {2, 6, 0}, {5, 6, 0}, {6, N_PHASES, 0}};
#elif MK_PLAN == 19
    const int plan[][3] = {{0, 4, 0}, {3, 4, 0}, {4, 9, 0}, {8, 9, 0}, {9, N_PHASES, 0}};
#elif MK_PLAN == 20
    const int plan[][3] = {{0, 2, 0}, {2, 3, 4 + 16 + 32 + 1024}, {2, 3, 0}, {3, N_PHASES, 0}};
#elif MK_PLAN == 21
    const int plan[][3] = {{0, 2, 0}, {2, 3, 4 + 16 + 32 + 2048}, {2, 3, 0}, {3, N_PHASES, 0}};
#elif MK_PLAN == 22
    const int plan[][3] = {{0, 2, 0}, {2, 3, 4 + 16 + 32 + 4096}, {2, 3, 0}, {3, N_PHASES, 0}};
#elif MK_PLAN == 23
    const int plan[][3] = {{0, 2, 0}, {2, 3, 4 + 16 + 32 + 16384}, {2, 3, 0}, {3, N_PHASES, 0}};
#elif MK_PLAN == 24
    const int plan[][3] = {{0, 2, 0}, {2, 3, 4 + 16 + 32 + 4096 + 16384}, {2, 3, 0}, {3, N_PHASES, 0}};
#elif MK_PLAN == 25
    const int plan[][3] = {{0, 2, 0}, {2, 3, 4 + 16 + 32}, {2, 3, 0}, {3, N_PHASES, 0}};
#elif MK_PLAN == 10
    const int plan[][3] = {{0, 3, 0}, {2, 3, 4 + 8}, {3, N_PHASES, 0}};
#endif
    const int nl = (int)(sizeof(plan) / sizeof(plan[0]));
    for (int li = 0; li < nl; ++li) {
        a.ph_lo = plan[li][0]; a.ph_hi = plan[li][1]; a.li = li; a.flags = plan[li][2];
        void* kargs[] = {&a};
        hipError_t e = hipLaunchCooperativeKernel((const void*)fwd_megakernel, dim3(grid), dim3(512), kargs, LDS_BYTES, stream);
        if (e != hipSuccess) { fprintf(stderr, "kernel_launch: cooperative launch %d failed: %s (grid %d)\n", li, hipGetErrorString(e), grid); break; }
    }
}
```

```cpp
#include <hip/hip_runtime.h>
#include <hip/hip_cooperative_groups.h>
#include <cstdio>
#include <cstdint>
namespace cg = cooperative_groups;
namespace pg8 {
#define PG8_LAS __attribute__((address_space(3)))
typedef unsigned short bf16_t;
typedef short bf16x8 __attribute__((ext_vector_type(8)));
typedef float f32x4 __attribute__((ext_vector_type(4)));
typedef unsigned u32x4 __attribute__((ext_vector_type(4)));
constexpr int BM = 256, BK = 64, HALF = 128, HTB = HALF * BK * 2  , STAGE_BYTES = 8 * HTB, NXCD = 8, WGM = 8;

__host__ __device__ __forceinline__ int lds_byte(int r, int c) { const int st = (r >> 4) * 2 + (c >> 5), rr = r & 15, cc = c & 31, ob = rr * 64 + cc * 2; return st * 1024 + (ob ^ (((ob >> 9) & 1) << 5)); }
__host__ __device__ __forceinline__ void stage_rc(int b, int& R, int& C) { const int st = b / 1024, sb = b % 1024, swz = sb ^ (((sb >> 9) & 1) << 5); R = (st >> 1) * 16 + swz / 64; C = (st & 1) * 32 + (swz % 64) / 2; }
__host__ __device__ __forceinline__ int perm32(int rho) { const int n = rho >> 4, i = rho & 15; return 8 * (i >> 2) + 4 * n + (i & 3); }

struct Unit { int pm, pn; };
struct Gemm { const bf16_t* A; const bf16_t* Bt; int M, N, K; };

struct StaticOrder {
    int nM, nN, nwg, G, c;
    __host__ __device__ void init(int M, int N, int G_, int c_) { nM = M / BM; nN = N / BM; nwg = nM * nN; G = G_; c = c_; }
    __host__ __device__ bool next(int i, Unit& u) const {
        const long L = (long)i * G + c; if (L >= nwg) return false;
        int wgid = (int)L; { const int q = nwg / NXCD, r = nwg % NXCD, xcd = wgid % NXCD, off = wgid / NXCD; wgid = (xcd < r ? xcd * (q + 1) : r * (q + 1) + (xcd - r) * q) + off; }
        const int nig = WGM * nN, gid = wgid / nig, fm = gid * WGM, gsz = (nM - fm) < WGM ? (nM - fm) : WGM;
        u.pm = fm + ((wgid % nig) % gsz); u.pn = (wgid % nig) / gsz; return true;
    }
    __device__ __forceinline__ void a_ready(const Unit&) const {}
    __device__ __forceinline__ void done(const Unit&) const {}
};

__device__ __forceinline__ unsigned cvt_pk_bf16(float lo, float hi) { unsigned r; asm volatile("v_cvt_pk_bf16_f32 %0, %1, %2" : "=v"(r) : "v"(lo), "v"(hi)); return r; }
typedef float f32x2 __attribute__((ext_vector_type(2)));
__device__ __forceinline__ f32x2 gelu_pk(f32x2 v) {
    const f32x2 av = __builtin_elementwise_abs(v), d = av * 0.2316418882f + 1.0f;
    f32x2 t; t.x = __builtin_amdgcn_rcpf(d.x); t.y = __builtin_amdgcn_rcpf(d.y);
    f32x2 q = t * 0.5307027145f + (-0.7265760135f); q = q * t + 0.7107068705f; q = q * t + (-0.142248368f); q = q * t + 0.127414796f; q = q * t;
    const f32x2 s = (v * v) * (-0.72134752044f);
    f32x2 e; e.x = __builtin_amdgcn_exp2f(s.x); e.y = __builtin_amdgcn_exp2f(s.y);
    const f32x2 m = v * (q * e), r = v - m;
    f32x2 o; o.x = v.x < 0.f ? m.x : r.x; o.y = v.y < 0.f ? m.y : r.y; return o;
}


struct EpiProj {
    static constexpr bool PERM = true, AFTER_DRAIN = false;
    bf16_t* U; int ldu; int n_main_pn; int mem_pm0; float* memf; bf16_t* memb;
    __device__ __forceinline__ void operator()(const f32x4 (&acc)[2][2][4][2], const Unit& u, int wr, int wc, int fr, int fq) const {
        if (u.pn < n_main_pn) {
            const int row0 = u.pm * BM + wr * 64 + fr, col0 = u.pn * BM + wc * 32 + 8 * fq;
#pragma unroll
            for (int ai = 0; ai < 2; ++ai)
#pragma unroll
                for (int m = 0; m < 4; ++m) { bf16_t* rowp = U + (size_t)(row0 + ai * HALF + m * 16) * ldu + col0;
#pragma unroll
                    for (int bj = 0; bj < 2; ++bj) { const f32x4 v0 = acc[ai][bj][m][0], v1 = acc[ai][bj][m][1]; u32x4 w;
                        w.x = cvt_pk_bf16(v0[0], v0[1]); w.y = cvt_pk_bf16(v0[2], v0[3]); w.z = cvt_pk_bf16(v1[0], v1[1]); w.w = cvt_pk_bf16(v1[2], v1[3]);
                        __builtin_nontemporal_store(w, (u32x4*)(rowp + bj * HALF)); } }
        } else {
            const int t = (u.pn - n_main_pn) >> 1, colt = ((u.pn - n_main_pn) & 1) * 256;
            const int row0 = (u.pm - mem_pm0) * BM + wr * 64 + fr, col0 = colt + wc * 32 + 8 * fq;
            float* fb = memf + (size_t)t * (2048 * 512); bf16_t* bb = memb + (size_t)t * (2048 * 512);
#pragma unroll
            for (int ai = 0; ai < 2; ++ai)
#pragma unroll
                for (int m = 0; m < 4; ++m) { const size_t ro = (size_t)(row0 + ai * HALF + m * 16) * 512 + col0;
#pragma unroll
                    for (int bj = 0; bj < 2; ++bj) { const f32x4 v0 = acc[ai][bj][m][0], v1 = acc[ai][bj][m][1]; u32x4 w;
                        __builtin_nontemporal_store(v0, (f32x4*)(fb + ro + bj * HALF)); __builtin_nontemporal_store(v1, (f32x4*)(fb + ro + bj * HALF + 4));
                        w.x = cvt_pk_bf16(v0[0], v0[1]); w.y = cvt_pk_bf16(v0[2], v0[3]); w.z = cvt_pk_bf16(v1[0], v1[1]); w.w = cvt_pk_bf16(v1[2], v1[3]);
                        *(u32x4*)(bb + ro + bj * HALF) = w; } }
        }
    }
};
struct EpiOut {
    static constexpr bool PERM = true, AFTER_DRAIN = false;
    bf16_t* Z; int mode; const bf16_t* xb; const bf16_t* zprev; const float* stats; const float* lnw; const float* lnb; float alpha;
    __device__ __forceinline__ static void unpack8(const u32x4 w, f32x4& lo, f32x4& hi) {
        lo = (f32x4){__uint_as_float(w.x << 16), __uint_as_float(w.x & 0xffff0000u), __uint_as_float(w.y << 16), __uint_as_float(w.y & 0xffff0000u)};
        hi = (f32x4){__uint_as_float(w.z << 16), __uint_as_float(w.z & 0xffff0000u), __uint_as_float(w.w << 16), __uint_as_float(w.w & 0xffff0000u)}; }
    __device__ __forceinline__ void operator()(const f32x4 (&acc)[2][2][4][2], const Unit& u, int wr, int wc, int fr, int fq) const {
        const int row0 = u.pm * BM + wr * 64 + fr, col0 = u.pn * BM + wc * 32 + 8 * fq;
        f32x4 lw[2][2], lb[2][2];
        if (mode == 1) {
#pragma unroll
            for (int bj = 0; bj < 2; ++bj) { lw[bj][0] = *(const f32x4*)(lnw + col0 + bj * HALF); lw[bj][1] = *(const f32x4*)(lnw + col0 + bj * HALF + 4);
                lb[bj][0] = *(const f32x4*)(lnb + col0 + bj * HALF); lb[bj][1] = *(const f32x4*)(lnb + col0 + bj * HALF + 4); }
        }
        const bf16_t* src = mode == 1 ? zprev : xb;
#pragma unroll
        for (int ai = 0; ai < 2; ++ai)
#pragma unroll
            for (int m = 0; m < 4; ++m) { const int row = row0 + ai * HALF + m * 16; const size_t ro = (size_t)row * 2048 + col0;
                float mu = 0.f, rs = 1.f; if (mode == 1) { mu = stats[2 * row]; rs = stats[2 * row + 1]; }
#pragma unroll
                for (int bj = 0; bj < 2; ++bj) { f32x4 r0, r1; unpack8(*(const u32x4*)(src + ro + bj * HALF), r0, r1);
                    if (mode == 1) { r0 = (r0 - mu) * rs * lw[bj][0] + lb[bj][0]; r1 = (r1 - mu) * rs * lw[bj][1] + lb[bj][1]; }
                    const f32x4 v0 = r0 * alpha + acc[ai][bj][m][0], v1 = r1 * alpha + acc[ai][bj][m][1]; u32x4 w;
                    w.x = cvt_pk_bf16(v0[0], v0[1]); w.y = cvt_pk_bf16(v0[2], v0[3]); w.z = cvt_pk_bf16(v1[0], v1[1]); w.w = cvt_pk_bf16(v1[2], v1[3]);
                    *(u32x4*)(Z + ro + bj * HALF) = w; } }
    }
};
struct OrderExt {
    StaticOrder so; int n_main, n_ext, ext_pm0, ext_pn0, ext_nm;
    __host__ __device__ void init(int M, int N, int G_, int c_, int n_ext_, int ext_pm0_, int ext_pn0_, int ext_nm_) { so.init(M, N, G_, c_); n_main = so.nwg; n_ext = n_ext_; ext_pm0 = ext_pm0_; ext_pn0 = ext_pn0_; ext_nm = ext_nm_; }
    __host__ __device__ bool next(int i, Unit& u) const {
        const long L = (long)i * so.G + so.c;
        if (L < n_main) return so.next(i, u);
        const int e = (int)(L - n_main); if (e >= n_ext) return false;
        u.pm = ext_pm0 + e % ext_nm; u.pn = ext_pn0 + e / ext_nm; return true;
    }
    __device__ __forceinline__ void a_ready(const Unit&) const {}
    __device__ __forceinline__ void done(const Unit&) const {}
};
template <class Epi, class Sched, bool ALIGN_EPI = false, bool SP2 = false>
__device__ __forceinline__ void gemm_phase(PG8_LAS unsigned char* lds, const Gemm g, const Sched& S, const Epi& E) {
    const int tid = threadIdx.x, wid = __builtin_amdgcn_readfirstlane(tid >> 6), lane = tid & 63, wr = wid >> 2, wc = wid & 3, fr = lane & 15, fq = lane >> 4;
    const int K = g.K, nt = K / BK;
    unsigned voffA[2], voffB[2];
#pragma unroll
    for (int i = 0; i < 2; ++i) { int R, C; stage_rc(tid * 16 + i * 8192, R, C); const int Rb = Epi::PERM ? ((R & ~31) + perm32(R & 31)) : R;
        voffA[i] = (unsigned)(R * K + C) * 2u; voffB[i] = (unsigned)(Rb * K + C) * 2u; }
    const size_t kstep = (size_t)(BK * 2);
    const size_t hstep = (size_t)HALF * K * 2;
    const size_t tstep = 2 * hstep;
    const unsigned ldsw = (unsigned)wid * 1024u;
    const int aoff = lds_byte(wr * 64 + fr, fq * 8), boff = lds_byte(wc * 32 + fr, fq * 8);
#define PG8_SA(b, h) (((b) * 2 + (h)) * HTB)
#define PG8_SB(b, h) ((4 + (b) * 2 + (h)) * HTB)
#define PG8_STAGE(bufoff, gbase, voff) do { _Pragma("unroll") for (int _i = 0; _i < 2; ++_i) \
        __builtin_amdgcn_global_load_lds((const unsigned*)((const char*)(gbase) + (voff)[_i]), (PG8_LAS unsigned*)(lds + (bufoff) + ldsw + _i * 8192), 16, 0, 0); } while (0)
#define PG8_LDA(dst, b, h) do { _Pragma("unroll") for (int m = 0; m < 4; ++m) _Pragma("unroll") for (int k = 0; k < 2; ++k) dst[m][k] = *(const PG8_LAS bf16x8*)(lds + PG8_SA(b, h) + aoff + m * 2048 + k * 1024); } while (0)
#define PG8_LDB(dst, b, h) do { _Pragma("unroll") for (int n = 0; n < 2; ++n) _Pragma("unroll") for (int k = 0; k < 2; ++k) dst[n][k] = *(const PG8_LAS bf16x8*)(lds + PG8_SB(b, h) + boff + n * 2048 + k * 1024); } while (0)
#define PG8_MMA(ai, bj, At, Bt) do { __builtin_amdgcn_s_setprio(1); _Pragma("unroll") for (int m = 0; m < 4; ++m) _Pragma("unroll") for (int n = 0; n < 2; ++n) _Pragma("unroll") for (int k = 0; k < 2; ++k) \
        acc[ai][bj][m][n] = __builtin_amdgcn_mfma_f32_16x16x32_bf16(Bt[n][k], At[m][k], acc[ai][bj][m][n], 0, 0, 0); __builtin_amdgcn_s_setprio(0); } while (0)
#define PG8_WAIT_V(n) asm volatile("s_waitcnt vmcnt(" #n ")" ::: "memory")
#define PG8_WAIT_L(n) asm volatile("s_waitcnt lgkmcnt(" #n ")" ::: "memory")
#define PG8_BAR __builtin_amdgcn_s_barrier()
#define PG8_SCHED __builtin_amdgcn_sched_barrier(0)
    Unit cur, nxt; int ui = 0;
    if (!S.next(0, cur)) return;
    f32x4 acc[2][2][4][2];
#pragma unroll
    for (int a = 0; a < 2; ++a)
#pragma unroll
        for (int b = 0; b < 2; ++b)
#pragma unroll
            for (int m = 0; m < 4; ++m)
#pragma unroll
                for (int n = 0; n < 2; ++n) acc[a][b][m][n] = (f32x4){0.f, 0.f, 0.f, 0.f};
    bf16x8 At[4][2], B0[2][2], B1[2][2];
    const char* cA = (const char*)g.A + (size_t)cur.pm * tstep; const char* cB = (const char*)g.Bt + (size_t)cur.pn * tstep;
    S.a_ready(cur);
    if constexpr (SP2) {
        PG8_STAGE(PG8_SB(0, 0), cB, voffB); PG8_STAGE(PG8_SB(0, 1), cB + hstep, voffB); PG8_STAGE(PG8_SA(0, 0), cA, voffA); PG8_STAGE(PG8_SA(0, 1), cA + hstep, voffA);
        if (wr == 1) PG8_BAR;
        PG8_WAIT_V(2); PG8_BAR;
        PG8_STAGE(PG8_SB(1, 0), cB + kstep, voffB); PG8_STAGE(PG8_SA(1, 0), cA + kstep, voffA); PG8_STAGE(PG8_SB(1, 1), cB + hstep + kstep, voffB);
        PG8_WAIT_V(6); PG8_BAR;
    } else {
        PG8_STAGE(PG8_SB(0, 0), cB, voffB); PG8_STAGE(PG8_SA(0, 0), cA, voffA); PG8_STAGE(PG8_SB(0, 1), cB + hstep, voffB); PG8_STAGE(PG8_SA(0, 1), cA + hstep, voffA);
        if (wr == 1) PG8_BAR;
        PG8_WAIT_V(4); PG8_BAR;
        PG8_STAGE(PG8_SB(1, 0), cB + kstep, voffB); PG8_STAGE(PG8_SA(1, 0), cA + kstep, voffA); PG8_STAGE(PG8_SB(1, 1), cB + hstep + kstep, voffB);
        PG8_WAIT_V(6); PG8_BAR;
    }
    for (;;) {
        const bool has_next = S.next(ui + 1, nxt);
        const char* nA = has_next ? (const char*)g.A + (size_t)nxt.pm * tstep : cA; const char* nB = has_next ? (const char*)g.Bt + (size_t)nxt.pn * tstep : cB;
        for (int t = 0; t < nt; t += 2) {
            const bool last = (t == nt - 2);
            const char* a1 = cA + (size_t)(t + 1) * kstep;
            const char* a2 = last ? nA : cA + (size_t)(t + 2) * kstep; const char* b2 = last ? nB : cB + (size_t)(t + 2) * kstep;
            const char* a3 = a2 + kstep; const char* b3 = b2 + kstep;
            if (last && has_next) S.a_ready(nxt);
            if constexpr (SP2) {
            PG8_LDB(B0, 0, 0); PG8_LDB(B1, 0, 1); PG8_SCHED; PG8_LDA(At, 0, 0); PG8_STAGE(PG8_SA(1, 1), a1 + hstep, voffA);
            PG8_WAIT_V(8); PG8_WAIT_L(0); PG8_BAR; PG8_MMA(0, 0, At, B0); PG8_MMA(0, 1, At, B1); PG8_BAR; PG8_SCHED;
            PG8_LDA(At, 0, 1); PG8_STAGE(PG8_SB(0, 0), b2, voffB); PG8_STAGE(PG8_SB(0, 1), b2 + hstep, voffB); PG8_STAGE(PG8_SA(0, 0), a2, voffA);
            PG8_WAIT_V(8); PG8_WAIT_L(0); PG8_BAR; PG8_MMA(1, 0, At, B0); PG8_MMA(1, 1, At, B1); PG8_BAR; PG8_SCHED;
            PG8_LDB(B0, 1, 0); PG8_LDB(B1, 1, 1); PG8_SCHED; PG8_LDA(At, 1, 0); PG8_STAGE(PG8_SA(0, 1), a2 + hstep, voffA);
            PG8_WAIT_V(8); PG8_WAIT_L(0); PG8_BAR; PG8_MMA(0, 0, At, B0); PG8_MMA(0, 1, At, B1); PG8_BAR; PG8_SCHED;
            PG8_LDA(At, 1, 1); PG8_STAGE(PG8_SB(1, 0), b3, voffB); PG8_STAGE(PG8_SB(1, 1), b3 + hstep, voffB); PG8_STAGE(PG8_SA(1, 0), a3, voffA);
            PG8_WAIT_V(8); PG8_WAIT_L(0); PG8_BAR; PG8_MMA(1, 0, At, B0); PG8_MMA(1, 1, At, B1); PG8_BAR; PG8_SCHED;
            } else {
            PG8_LDB(B0, 0, 0); PG8_SCHED; PG8_LDA(At, 0, 0); PG8_STAGE(PG8_SA(1, 1), a1 + hstep, voffA);
            PG8_WAIT_L(8); PG8_BAR; PG8_WAIT_L(0); PG8_MMA(0, 0, At, B0); PG8_BAR; PG8_SCHED;
            PG8_LDB(B1, 0, 1); PG8_STAGE(PG8_SB(0, 0), b2, voffB);
            PG8_BAR; PG8_WAIT_L(0); PG8_MMA(0, 1, At, B1); PG8_BAR;
            PG8_LDA(At, 0, 1); PG8_STAGE(PG8_SA(0, 0), a2, voffA);
            PG8_BAR; PG8_WAIT_L(0); PG8_MMA(1, 0, At, B0); PG8_BAR; PG8_SCHED;
            PG8_STAGE(PG8_SB(0, 1), b2 + hstep, voffB);
            PG8_WAIT_V(6); PG8_BAR; PG8_MMA(1, 1, At, B1); PG8_BAR;
            PG8_LDB(B0, 1, 0); PG8_SCHED; PG8_LDA(At, 1, 0); PG8_STAGE(PG8_SA(0, 1), a2 + hstep, voffA);
            PG8_WAIT_L(8); PG8_BAR; PG8_WAIT_L(0); PG8_MMA(0, 0, At, B0); PG8_BAR; PG8_SCHED;
            PG8_LDB(B1, 1, 1); PG8_STAGE(PG8_SB(1, 0), b3, voffB);
            PG8_BAR; PG8_WAIT_L(0); PG8_MMA(0, 1, At, B1); PG8_BAR;
            PG8_LDA(At, 1, 1); PG8_STAGE(PG8_SA(1, 0), a3, voffA);
            PG8_BAR; PG8_WAIT_L(0); PG8_MMA(1, 0, At, B0); PG8_BAR; PG8_SCHED;
            PG8_STAGE(PG8_SB(1, 1), b3 + hstep, voffB);
            PG8_WAIT_V(6); PG8_BAR; PG8_MMA(1, 1, At, B1); PG8_BAR;
            }
        }
        if constexpr (ALIGN_EPI) { if (wr == 0) PG8_BAR; }
        if constexpr (!Epi::AFTER_DRAIN) { E(acc, cur, wr, wc, fr, fq); S.done(cur); }
        if (!has_next) break;
#pragma unroll
        for (int a = 0; a < 2; ++a)
#pragma unroll
            for (int b = 0; b < 2; ++b)
#pragma unroll
                for (int m = 0; m < 4; ++m)
#pragma unroll
                    for (int n = 0; n < 2; ++n) acc[a][b][m][n] = (f32x4){0.f, 0.f, 0.f, 0.f};
        cur = nxt; cA = nA; cB = nB; ++ui;
        if constexpr (ALIGN_EPI) { if (wr == 1) PG8_BAR; }
    }
    PG8_WAIT_V(0);
    if constexpr (!ALIGN_EPI) { if (wr == 0) PG8_BAR; }
    PG8_BAR;
    if constexpr (Epi::AFTER_DRAIN) { E.fused(acc, cur, wr, wc, fr, fq, lds, wid, lane); S.done(cur); }
#undef PG8_SA
#undef PG8_SB
#undef PG8_STAGE
#undef PG8_LDA
#undef PG8_LDB
#undef PG8_MMA
#undef PG8_WAIT_V
#undef PG8_WAIT_L
#undef PG8_BAR
#undef PG8_SCHED
}
}

constexpr int DM = 2048, NB = 8, SEQ = 2048, NTOK = NB * SEQ, NDEC = 128;
constexpr int ROW_S = NTOK;
constexpr int ROWS_ACT = NTOK + 256;
constexpr int ROW_MEM = ROWS_ACT;
constexpr int A0_ROWS = ROWS_ACT + 2048;
constexpr int N0 = 4608, N1 = 7168;
constexpr float ALPHA = 1.41421356237f;
constexpr size_t O_YP = 0, O_YS = 33554432, O_MK = 33816576, O_MV = 35913728, O_SKP = 38010880, O_SVP = 38273024, O_HSP = 38535168, O_SKS = 40108032, O_SVS = 44302336, O_HSS = 48496640, O_END = 73662464;
constexpr size_t MiB = 1u << 20;
constexpr size_t WS_CTL = 0, WS_WT0 = 1 * MiB, WS_WT1 = 27 * MiB, WS_WO = 55 * MiB, WS_MKVB = 71 * MiB, WS_MISC = 79 * MiB, WS_R1 = 80 * MiB;
constexpr size_t WS_A0 = WS_R1, WS_U0 = WS_R1 + 73 * MiB, WS_U1 = WS_R1, WS_BR = 308 * MiB, WS_Z0 = 373 * MiB, WS_Z1 = 438 * MiB  , WS_H1 = 503 * MiB, WS_HG = 503 * MiB  , WS_END = 625 * MiB;
static_assert((size_t)A0_ROWS * DM * 2 <= 73 * MiB && WS_U0 + (size_t)ROWS_ACT * N0 * 2 <= WS_BR && WS_U1 + (size_t)ROWS_ACT * N1 * 2 <= WS_BR, "ws map");
static_assert(WS_BR + (size_t)ROWS_ACT * DM * 2 <= WS_Z0 && WS_Z0 + (size_t)ROWS_ACT * DM * 2 <= WS_Z1 && WS_Z1 + (size_t)ROWS_ACT * DM * 2 <= WS_H1 && WS_H1 + (size_t)ROWS_ACT * DM * 2 <= WS_END && WS_HG + (size_t)3072 * 41472 <= WS_END, "ws map");
constexpr int LDS_BYTES = 147456;

#define LAS __attribute__((address_space(3)))
typedef unsigned short bf16;
typedef unsigned v4u __attribute__((ext_vector_type(4)));
typedef unsigned v2u __attribute__((ext_vector_type(2)));
typedef float f32x4 __attribute__((ext_vector_type(4)));
typedef float f32x2 __attribute__((ext_vector_type(2)));
typedef short bf16x8 __attribute__((ext_vector_type(8)));
typedef short s16x4 __attribute__((ext_vector_type(4)));
typedef __bf16 bf16x2_t __attribute__((ext_vector_type(2)));
#define LDS_WAIT() asm volatile("s_waitcnt lgkmcnt(0)" ::: "memory")
#define LDS_BARRIER() do { asm volatile("s_waitcnt lgkmcnt(0)" ::: "memory"); __builtin_amdgcn_s_barrier(); asm volatile("" ::: "memory"); } while (0)

__device__ __forceinline__ float bf2f(unsigned short b) { return __uint_as_float((unsigned)b << 16); }
__device__ __forceinline__ unsigned pk2(float lo, float hi) { f32x2 v = {lo, hi}; bf16x2_t b = __builtin_convertvector(v, bf16x2_t); return __builtin_bit_cast(unsigned, b); }
__device__ __forceinline__ unsigned short f2bf(float f) { return (unsigned short)(pk2(f, 0.f) & 0xffffu); }
__device__ __forceinline__ float fast_rcp(float x) { return __builtin_amdgcn_rcpf(x); }
__device__ __forceinline__ float silu_f(float x) { return x * fast_rcp(1.f + __expf(-x)); }
__device__ __forceinline__ float sigmoid_f(float x) { return fast_rcp(1.f + __expf(-x)); }
__device__ __forceinline__ s16x4 vtr(const LAS unsigned char* p) { typedef short v4i16_t __attribute__((ext_vector_type(4))); return __builtin_bit_cast(s16x4, __builtin_amdgcn_ds_read_tr16_b64_v4i16((LAS v4i16_t*)p)); }
__device__ __forceinline__ float wave_sum(float v) {
#pragma unroll
    for (int o = 1; o < 64; o <<= 1) v += __shfl_xor(v, o);
    return v;
}
__device__ __forceinline__ float wave_max(float v) {
#pragma unroll
    for (int o = 1; o < 64; o <<= 1) v = fmaxf(v, __shfl_xor(v, o));
    return v;
}

__device__ __forceinline__ const unsigned char* uni_ptr(const void* p) { const unsigned long long v = (unsigned long long)p;
    const unsigned lo = __builtin_amdgcn_readfirstlane((unsigned)v), hi = __builtin_amdgcn_readfirstlane((unsigned)(v >> 32)); return (const unsigned char*)(((unsigned long long)hi << 32) | lo); }

struct Frame {
    LAS unsigned char* lds;
    int tid, lane, wave, G, bid;
    const float* in[19]; float* out; unsigned char* ws;
};

__device__ __forceinline__ void p0_transpose_item(const float* W, int K, int N, bf16* WT, int row_off, LAS float* scr, int item, int lane) {
    const int nblk = N / 32, kb = item / nblk, nb = item % nblk, k0 = 64 * kb, n0 = 32 * nb;
    const int kr = lane >> 3, c4 = lane & 7; f32x4 v[8];
#pragma unroll
    for (int i = 0; i < 8; ++i) v[i] = __builtin_nontemporal_load((const f32x4*)(W + (size_t)(k0 + 8 * i + kr) * N + n0 + 4 * c4));
#pragma unroll
    for (int i = 0; i < 8; ++i) { LAS float* d = scr + (8 * i + kr) * 33 + 4 * c4; d[0] = v[i].x; d[1] = v[i].y; d[2] = v[i].z; d[3] = v[i].w; }
    LDS_WAIT(); asm volatile("" ::: "memory");
    const int c = lane & 7;
#pragma unroll
    for (int j = 0; j < 4; ++j) { const int n = (lane >> 3) + 8 * j; const LAS float* s = scr + (8 * c) * 33 + n;
        v4u o; o.x = pk2(s[0 * 33], s[1 * 33]); o.y = pk2(s[2 * 33], s[3 * 33]); o.z = pk2(s[4 * 33], s[5 * 33]); o.w = pk2(s[6 * 33], s[7 * 33]);
        *(v4u*)(WT + (size_t)(row_off + n0 + n) * K + k0 + 8 * c) = o; }
    LDS_WAIT(); asm volatile("" ::: "memory");
}
__device__ __forceinline__ void cvt_row(const float* src, bf16* dst, int lane) {
    const f32x4* s = (const f32x4*)src + lane; v2u* d = (v2u*)dst + lane;
#pragma unroll
    for (int j = 0; j < 8; ++j) { const f32x4 v = __builtin_nontemporal_load(s + 64 * j); v2u o; o.x = pk2(v.x, v.y); o.y = pk2(v.z, v.w); d[64 * j] = o; }
}
__device__ __forceinline__ void p0_prologue(Frame& F) {
    LAS float* scr = (LAS float*)(F.lds + F.wave * 16384);
    const int gw = F.bid * 8 + F.wave, NGW = F.G * 8;
    bf16* WT0 = (bf16*)(F.ws + WS_WT0); bf16* WT1 = (bf16*)(F.ws + WS_WT1); bf16* WO = (bf16*)(F.ws + WS_WO); bf16* A0 = (bf16*)(F.ws + WS_A0);
    constexpr int I_IN0 = 32 * (N0 / 32), I_MEM = 32 * 16, I_IN1 = 32 * (N1 / 32), I_OUT = 32 * 64;
    constexpr int NITEMS = I_IN0 + 4 * I_MEM + I_IN1 + 2 * I_OUT;
    for (int it = gw; it < NITEMS; it += NGW) {
        int r = it;
        if (r < I_IN0) { p0_transpose_item(F.in[9], DM, N0, WT0, 0, scr, r, F.lane); continue; } r -= I_IN0;
        if (r < 4 * I_MEM) { const int t = r / I_MEM; const float* w = (t < 2 ? F.in[14] : F.in[15]) + (size_t)(t & 1) * DM * 512;
            p0_transpose_item(w, DM, 512, WT0, N0 + 512 * t, scr, r % I_MEM, F.lane); continue; } r -= 4 * I_MEM;
        if (r < I_IN1) { p0_transpose_item(F.in[11], DM, N1, WT1, 0, scr, r, F.lane); continue; } r -= I_IN1;
        { const int l = r / I_OUT; p0_transpose_item(F.in[16] + (size_t)l * DM * DM, DM, DM, WO + (size_t)l * DM * DM, 0, scr, r % I_OUT, F.lane); }
    }
    for (int m = gw; m < A0_ROWS; m += NGW) {
        bf16* dst = A0 + (size_t)m * DM;
        if (m < NTOK) cvt_row(F.in[0] + (size_t)m * DM, dst, F.lane);
        else if (m < NTOK + NDEC) cvt_row(F.in[1] + (size_t)(m - NTOK) * DM, dst, F.lane);
        else if (m < ROW_MEM) { v4u z = {0u, 0u, 0u, 0u}; v4u* d = (v4u*)dst + F.lane;
#pragma unroll
            for (int j = 0; j < 4; ++j) d[64 * j] = z; }
        else cvt_row(F.in[7] + (size_t)(m - ROW_MEM) * DM, dst, F.lane);
    }
}

__device__ __forceinline__ void ln_row(const bf16* z, const float* w, const float* bb, bf16* obf, float* of32, float* st, int lane) {
    const v4u* zr = (const v4u*)z + lane; float v[32]; float s = 0.f;
#pragma unroll
    for (int j = 0; j < 4; ++j) { const v4u q = __builtin_nontemporal_load(zr + 64 * j);
        v[8 * j + 0] = __uint_as_float(q.x << 16); v[8 * j + 1] = __uint_as_float(q.x & 0xffff0000u); v[8 * j + 2] = __uint_as_float(q.y << 16); v[8 * j + 3] = __uint_as_float(q.y & 0xffff0000u);
        v[8 * j + 4] = __uint_as_float(q.z << 16); v[8 * j + 5] = __uint_as_float(q.z & 0xffff0000u); v[8 * j + 6] = __uint_as_float(q.w << 16); v[8 * j + 7] = __uint_as_float(q.w & 0xffff0000u);
#pragma unroll
        for (int i = 0; i < 8; ++i) s += v[8 * j + i]; }
    const float mean = wave_sum(s) * (1.f / DM); float s2 = 0.f;
#pragma unroll
    for (int i = 0; i < 32; ++i) { v[i] -= mean; s2 += v[i] * v[i]; }
    const float rstd = 1.f / sqrtf(wave_sum(s2) * (1.f / DM) + 1e-5f);
    if (st && lane == 0) { st[0] = mean; st[1] = rstd; }
#pragma unroll
    for (int j = 0; j < 4; ++j) { const int e0 = (lane + 64 * j) * 8; const f32x4 w0 = *(const f32x4*)(w + e0), w1 = *(const f32x4*)(w + e0 + 4), b0 = *(const f32x4*)(bb + e0), b1 = *(const f32x4*)(bb + e0 + 4);
        const f32x4 y0 = (f32x4){v[8 * j], v[8 * j + 1], v[8 * j + 2], v[8 * j + 3]} * rstd * w0 + b0, y1 = (f32x4){v[8 * j + 4], v[8 * j + 5], v[8 * j + 6], v[8 * j + 7]} * rstd * w1 + b1;
        if (of32) { __builtin_nontemporal_store(y0, (f32x4*)(of32 + e0)); __builtin_nontemporal_store(y1, (f32x4*)(of32 + e0 + 4)); }
        if (obf) { v4u o; o.x = pk2(y0.x, y0.y); o.y = pk2(y0.z, y0.w); o.z = pk2(y1.x, y1.y); o.w = pk2(y1.z, y1.w); *(v4u*)(obf + e0) = o; } }
}

__device__ __forceinline__ void build_bias_tab(Frame& F, LAS float* tab) {
    const float* rb = F.in[8];
    for (int i = F.tid; i < 24 * 128; i += 512) { const int h = i >> 7, d = i & 127; int bk;
        if (d < 16) bk = d; else { bk = 16 + (int)(logf((float)d / 16.f) / 2.0794415416798357f * 16.f); bk = bk < 31 ? bk : 31; }
        tab[i] = rb[bk * 24 + h]; }
}
constexpr int SWA_TABR = 131072, TABR_LD = 160;
__device__ __forceinline__ void build_bias_tabr(Frame& F, const LAS float* tab, LAS float* tabr) {
    for (int i = F.tid; i < 24 * TABR_LD; i += 512) { const int h = i / TABR_LD, x = i % TABR_LD, d = 16 + 127 - x; tabr[i] = (d >= 0 && d < 128) ? tab[h * 128 + d] * 1.4426950408889634f : 0.f; }
}
constexpr int SWA_ROWS = 400, SWA_KS = 0, SWA_VS = SWA_ROWS * 144, SWA_TAB = 2 * SWA_ROWS * 144;
static_assert(SWA_TAB + 24 * 128 * 4 <= SWA_TABR, "SWA LDS map");
__device__ __forceinline__ void swa_prompt_unit(Frame& F, int b, int kvh, int qb4) {
    const bf16* U0 = (const bf16*)(F.ws + WS_U0); bf16* BR = (bf16*)(F.ws + WS_BR);
    LAS unsigned char* Ks = F.lds + SWA_KS; LAS unsigned char* Vs = F.lds + SWA_VS; const LAS float* tabr = (const LAS float*)(F.lds + SWA_TABR);
    const int q00 = qb4 * 256, lane = F.lane, fr = lane & 15, fq = lane >> 4;
    __syncthreads();
    { v4u tb[13];
#pragma unroll
      for (int i = 0; i < 13; ++i) { const int id = F.tid + 512 * i, which = id >= SWA_ROWS * 8, rem = id - which * (SWA_ROWS * 8), r = rem >> 3, ch = rem & 7; const int kp = q00 - 128 + r;
          tb[i] = (v4u){0u, 0u, 0u, 0u};
          if (id < 2 * SWA_ROWS * 8 && r < 384 && kp >= 0) tb[i] = *(const v4u*)(U0 + (size_t)(b * SEQ + kp) * N0 + 1536 + which * 256 + kvh * 64 + ch * 8); }
#pragma unroll
      for (int i = 0; i < 13; ++i) { const int id = F.tid + 512 * i, which = id >= SWA_ROWS * 8, rem = id - which * (SWA_ROWS * 8), r = rem >> 3, ch = rem & 7;
          if (id < 2 * SWA_ROWS * 8) *(LAS v4u*)((which ? Vs : Ks) + r * 144 + ch * 16) = tb[i]; } }
    __syncthreads();
    const float* sinks = F.in[10];
#pragma unroll 1
    for (int su = 0; su < 4; ++su) {
    const int q0 = q00 + 64 * su; LAS unsigned char* Ksu = Ks + su * 64 * 144; LAS unsigned char* Vsu = Vs + su * 64 * 144;
    bf16x8 qf[3][2]; v2u gv[3][4];
#pragma unroll
    for (int j = 0; j < 3; ++j) { const int gi = F.wave * 3 + j, head = kvh * 6 + (gi >> 2); const size_t qrow = (size_t)(b * SEQ + q0 + (gi & 3) * 16 + fr);
#pragma unroll
        for (int ks = 0; ks < 2; ++ks) qf[j][ks] = __builtin_nontemporal_load((const bf16x8*)(U0 + qrow * N0 + head * 64 + ks * 32 + fq * 8));
#pragma unroll
        for (int dt = 0; dt < 4; ++dt) gv[j][dt] = __builtin_nontemporal_load((const v2u*)(U0 + qrow * N0 + 2560 + head * 64 + 16 * dt + 4 * fq)); }
#pragma unroll
    for (int j = 0; j < 3; ++j) {
        const int gi = F.wave * 3 + j, g = gi >> 2, qsub = gi & 3, head = kvh * 6 + g, qs = q0 + qsub * 16;
        const size_t qrow = (size_t)(b * SEQ + qs + fr);
        f32x4 sacc[9];
#pragma unroll
        for (int T3 = 0; T3 < 3; ++T3) { bf16x8 kf[3][2];
#pragma unroll
            for (int t = 0; t < 3; ++t)
#pragma unroll
                for (int ks = 0; ks < 2; ++ks) kf[t][ks] = *(const LAS bf16x8*)(Ksu + (qsub * 16 + 16 * (3 * T3 + t) + fr) * 144 + (ks * 32 + fq * 8) * 2);
            __builtin_amdgcn_sched_barrier(0);
#pragma unroll
            for (int t = 0; t < 3; ++t) { f32x4 a = {0.f, 0.f, 0.f, 0.f};
#pragma unroll
                for (int ks = 0; ks < 2; ++ks) a = __builtin_amdgcn_mfma_f32_16x16x32_bf16(kf[t][ks], qf[j][ks], a, 0, 0, 0);
                sacc[3 * T3 + t] = a; }
            __builtin_amdgcn_sched_barrier(0); }
        const float L2E = 1.4426950408889634f; const float sink2 = sinks[head] * L2E; float mx = sink2;
        const LAS float* tb = tabr + head * TABR_LD + 15 - fr + 4 * fq; const int kmin = 128 - qs;
#pragma unroll
        for (int T = 0; T < 9; ++T) {
#pragma unroll
            for (int r = 0; r < 4; ++r) { float s = __builtin_fmaf(sacc[T][r], 0.125f * L2E, tb[16 * T + r]);
                if (T == 0) s = (4 * fq + r > fr) ? s : -INFINITY;
                if (T == 8) s = (4 * fq + r <= fr) ? s : -INFINITY;
                sacc[T][r] = s; }
            if (16 * T < kmin) sacc[T] = (f32x4){-INFINITY, -INFINITY, -INFINITY, -INFINITY};
            mx = fmaxf(mx, fmaxf(fmaxf(sacc[T][0], sacc[T][1]), fmaxf(sacc[T][2], sacc[T][3]))); }
        mx = fmaxf(mx, __shfl_xor(mx, 16)); mx = fmaxf(mx, __shfl_xor(mx, 32));
        float sum = 0.f;
#pragma unroll
        for (int T = 0; T < 9; ++T)
#pragma unroll
            for (int r = 0; r < 4; ++r) { const float p = __builtin_amdgcn_exp2f(sacc[T][r] - mx); sacc[T][r] = p; sum += p; }
        sum += __shfl_xor(sum, 16); sum += __shfl_xor(sum, 32);
        const float inv = 1.f / (sum + __builtin_amdgcn_exp2f(sink2 - mx));
        bf16x8 pf[5];
#pragma unroll
        for (int mm = 0; mm < 5; ++mm) { v4u w; w.x = pk2(sacc[2 * mm][0], sacc[2 * mm][1]); w.y = pk2(sacc[2 * mm][2], sacc[2 * mm][3]);
            if (mm < 4) { w.z = pk2(sacc[2 * mm + 1][0], sacc[2 * mm + 1][1]); w.w = pk2(sacc[2 * mm + 1][2], sacc[2 * mm + 1][3]); } else { w.z = 0u; w.w = 0u; }
            pf[mm] = __builtin_bit_cast(bf16x8, w); }
        f32x4 oacc[4];
#pragma unroll
        for (int d2 = 0; d2 < 2; ++d2) { s16x4 vlo[2][5], vhi[2][5];
#pragma unroll
            for (int t = 0; t < 2; ++t)
#pragma unroll
                for (int mm = 0; mm < 5; ++mm) { const LAS unsigned char* vp = Vsu + (qsub * 16 + 32 * mm + 4 * fq + (fr >> 2)) * 144 + (16 * (2 * d2 + t) + 4 * (fr & 3)) * 2; vlo[t][mm] = vtr(vp); vhi[t][mm] = vtr(vp + 16 * 144); }
            __builtin_amdgcn_sched_barrier(0);
#pragma unroll
            for (int t = 0; t < 2; ++t) { f32x4 a = {0.f, 0.f, 0.f, 0.f};
#pragma unroll
                for (int mm = 0; mm < 5; ++mm) { const bf16x8 vf = (bf16x8){vlo[t][mm][0], vlo[t][mm][1], vlo[t][mm][2], vlo[t][mm][3], vhi[t][mm][0], vhi[t][mm][1], vhi[t][mm][2], vhi[t][mm][3]};
                    a = __builtin_amdgcn_mfma_f32_16x16x32_bf16(vf, pf[mm], a, 0, 0, 0); }
                oacc[2 * d2 + t] = a; }
            __builtin_amdgcn_sched_barrier(0); }
#pragma unroll
        for (int dt = 0; dt < 4; ++dt) { const int col = head * 64 + 16 * dt + 4 * fq; const v2u g2 = gv[j][dt];
            const float g0 = bf2f((unsigned short)(g2.x & 0xffff)), g1 = bf2f((unsigned short)(g2.x >> 16)), g2f = bf2f((unsigned short)(g2.y & 0xffff)), g3 = bf2f((unsigned short)(g2.y >> 16));
            v2u o; o.x = pk2(oacc[dt][0] * inv * silu_f(g0), oacc[dt][1] * inv * silu_f(g1)); o.y = pk2(oacc[dt][2] * inv * silu_f(g2f), oacc[dt][3] * inv * silu_f(g3));
            *(v2u*)(BR + qrow * DM + col) = o; }
        asm volatile("" ::: "memory");
    }
    }
}

constexpr int MEM_KS = 0, MEM_VS = 256 * 272, MEM_VST = 288;
__device__ __forceinline__ void mem_prompt_unit(Frame& F, int layer, int b, int h, int qblk, const bf16* U, int ldu, int mq_col0, int gate_col0, int vflags = 0) {
    const bf16* MK = (const bf16*)(F.ws + WS_MKVB) + (size_t)layer * (2048 * 512); const bf16* MV = MK + (size_t)2 * (2048 * 512);
    bf16* BR = (bf16*)(F.ws + WS_BR);
    LAS unsigned char* Ks = F.lds + MEM_KS; LAS unsigned char* Vs = F.lds + MEM_VS;
    const int lane = F.lane, fr = lane & 15, fq = lane >> 4;
    bf16x8 qfa[2][4];
#pragma unroll
    for (int j = 0; j < 2; ++j) { const size_t qrow = (size_t)(b * SEQ + qblk * 256 + (F.wave * 2 + j) * 16 + fr);
#pragma unroll
        for (int ks = 0; ks < 4; ++ks) qfa[j][ks] = __builtin_nontemporal_load((const bf16x8*)(U + qrow * ldu + mq_col0 + h * 128 + ks * 32 + fq * 8)); }
    __syncthreads();
    if (!(vflags & 1024)) { v4u tb[16];
#pragma unroll
      for (int i = 0; i < 16; ++i) { const int id = F.tid + 512 * i, which = i >> 3, rem = id & 4095, r = rem >> 4, ch = rem & 15;
          tb[i] = *(const v4u*)((which ? MV : MK) + (size_t)(b * 256 + r) * 512 + h * 128 + ch * 8); }
#pragma unroll
      for (int i = 0; i < 16; ++i) { const int id = F.tid + 512 * i, which = i >> 3, rem = id & 4095, r = rem >> 4, ch = rem & 15;
          *(LAS v4u*)((which ? Vs + r * MEM_VST : Ks + r * 272) + ch * 16) = tb[i]; } }
    __syncthreads();
    const float cexp = 0.08838834764831845f * 1.4426950408889634f;
    if (vflags & 2048) return;
#define SB() __builtin_amdgcn_sched_barrier(0)
#pragma unroll
    for (int j = 0; j < 2; ++j) {
        const int qs = qblk * 256 + (F.wave * 2 + j) * 16; const size_t qrow = (size_t)(b * SEQ + qs + fr);
        v2u gva[8];
#pragma unroll
        for (int dt = 0; dt < 8; ++dt) gva[dt] = __builtin_nontemporal_load((const v2u*)(U + qrow * ldu + gate_col0 + 1536 + h * 128 + 16 * dt + 4 * fq));
        f32x4 sacc[16]; float mx = -INFINITY;
#pragma unroll
        for (int T2 = 0; T2 < 8; ++T2) { bf16x8 kf[2][4];
            if (vflags & 4096) { sacc[2 * T2] = (f32x4){0.f, 1.f, 2.f, 3.f}; sacc[2 * T2 + 1] = (f32x4){1.f, 0.f, 3.f, 2.f}; continue; }
#pragma unroll
            for (int t = 0; t < 2; ++t)
#pragma unroll
                for (int ks = 0; ks < 4; ++ks) kf[t][ks] = *(const LAS bf16x8*)(Ks + (16 * (2 * T2 + t) + fr) * 272 + (ks * 32 + fq * 8) * 2);
            SB();
#pragma unroll
            for (int t = 0; t < 2; ++t) { f32x4 a = {0.f, 0.f, 0.f, 0.f};
#pragma unroll
                for (int ks = 0; ks < 4; ++ks) a = __builtin_amdgcn_mfma_f32_16x16x32_bf16(kf[t][ks], qfa[j][ks], a, 0, 0, 0);
                sacc[2 * T2 + t] = a; }
            SB(); }
#pragma unroll
        for (int T = 0; T < 16; ++T) mx = fmaxf(mx, fmaxf(fmaxf(sacc[T][0], sacc[T][1]), fmaxf(sacc[T][2], sacc[T][3])));
        mx = fmaxf(mx, __shfl_xor(mx, 16)); mx = fmaxf(mx, __shfl_xor(mx, 32));
        const float nmx = -mx * cexp; float sum = 0.f; bf16x8 pf[8];
#pragma unroll
        for (int mm = 0; mm < 8; ++mm) { float p[8];
#pragma unroll
            for (int r = 0; r < 4; ++r) { if (vflags & 8192) { p[r] = sacc[2 * mm][r]; p[4 + r] = sacc[2 * mm + 1][r]; } else { p[r] = __builtin_amdgcn_exp2f(__builtin_fmaf(sacc[2 * mm][r], cexp, nmx)); p[4 + r] = __builtin_amdgcn_exp2f(__builtin_fmaf(sacc[2 * mm + 1][r], cexp, nmx)); } sum += p[r] + p[4 + r]; }
            v4u w; w.x = pk2(p[0], p[1]); w.y = pk2(p[2], p[3]); w.z = pk2(p[4], p[5]); w.w = pk2(p[6], p[7]); pf[mm] = __builtin_bit_cast(bf16x8, w); }
        sum += __shfl_xor(sum, 16); sum += __shfl_xor(sum, 32);
        const float inv = 1.f / sum;
#pragma unroll
        for (int d2 = 0; d2 < 4; ++d2) { s16x4 vlo[2][8], vhi[2][8];
            if (vflags & 16384) continue;
#pragma unroll
            for (int t = 0; t < 2; ++t)
#pragma unroll
                for (int mm = 0; mm < 8; ++mm) { const LAS unsigned char* vp = Vs + (32 * mm + 4 * fq + (fr >> 2)) * MEM_VST + (16 * (2 * d2 + t) + 4 * (fr & 3)) * 2; vlo[t][mm] = vtr(vp); vhi[t][mm] = vtr(vp + 16 * MEM_VST); }
            SB();
            f32x4 oacc[2];
#pragma unroll
            for (int t = 0; t < 2; ++t) { oacc[t] = (f32x4){0.f, 0.f, 0.f, 0.f};
#pragma unroll
                for (int mm = 0; mm < 8; ++mm) { const bf16x8 vf = (bf16x8){vlo[t][mm][0], vlo[t][mm][1], vlo[t][mm][2], vlo[t][mm][3], vhi[t][mm][0], vhi[t][mm][1], vhi[t][mm][2], vhi[t][mm][3]};
                    oacc[t] = __builtin_amdgcn_mfma_f32_16x16x32_bf16(vf, pf[mm], oacc[t], 0, 0, 0); } }
            SB();
#pragma unroll
            for (int t = 0; t < 2; ++t) { const int dt = 2 * d2 + t, col = h * 128 + 16 * dt + 4 * fq; const v2u gv = gva[dt];
                const float g0 = __uint_as_float(gv.x << 16), g1 = __uint_as_float(gv.x & 0xffff0000u), g2 = __uint_as_float(gv.y << 16), g3 = __uint_as_float(gv.y & 0xffff0000u);
                v2u o; o.x = pk2(oacc[t][0] * inv * silu_f(g0), oacc[t][1] * inv * silu_f(g1)); o.y = pk2(oacc[t][2] * inv * silu_f(g2), oacc[t][3] * inv * silu_f(g3));
                *(v2u*)(BR + qrow * DM + 1536 + col) = o; } }
    }
#undef SB
}

__device__ __forceinline__ void swa_sample_unit(Frame& F, int b, const LAS float* tab) {
    const bf16* U0 = (const bf16*)(F.ws + WS_U0); bf16* BR = (bf16*)(F.ws + WS_BR);
    LAS float* red = (LAS float*)(F.lds);
    LAS float* qf = (LAS float*)(F.lds + 73728);
    LAS float* kn = qf + 1536;
    LAS float* vn = kn + 256;
    LAS float* sc = vn + 256;
    LAS float* pinv = sc + 24 * 128;
    const size_t row = (size_t)(ROW_S + b);
    const float* ck = F.in[4] + (size_t)b * 128 * 256; const float* cv = F.in[5] + (size_t)b * 128 * 256;
    float* ok = F.out + O_SKS + (size_t)b * 128 * 256; float* ov = F.out + O_SVS + (size_t)b * 128 * 256;
    __syncthreads();
    for (int i = F.tid; i < 2048; i += 512) { const float v = bf2f(U0[row * N0 + i]); if (i < 1536) qf[i] = v; else if (i < 1792) kn[i - 1536] = v; else vn[i - 1792] = v; }
    __syncthreads();
    { const int j = F.tid >> 2, kvh = F.tid & 3; f32x4 kr[16];
#pragma unroll
      for (int c4 = 0; c4 < 16; ++c4) { if (j < 127) kr[c4] = __builtin_nontemporal_load((const f32x4*)(ck + (j + 1) * 256 + kvh * 64 + c4 * 4)); else kr[c4] = *(const LAS f32x4*)(kn + kvh * 64 + c4 * 4); }
      float acc[6] = {0.f, 0.f, 0.f, 0.f, 0.f, 0.f};
#pragma unroll
      for (int c4 = 0; c4 < 16; ++c4) { __builtin_nontemporal_store(kr[c4], (f32x4*)(ok + j * 256 + kvh * 64 + c4 * 4));
#pragma unroll
          for (int g = 0; g < 6; ++g) { const f32x4 q = *(const LAS f32x4*)(qf + (kvh * 6 + g) * 64 + c4 * 4); acc[g] += kr[c4].x * q.x + kr[c4].y * q.y + kr[c4].z * q.z + kr[c4].w * q.w; } }
#pragma unroll
      for (int g = 0; g < 6; ++g) { const int head = kvh * 6 + g; sc[head * 128 + j] = acc[g] * 0.125f + tab[head * 128 + (127 - j)]; } }
    const int vkvh = F.tid >> 7, jq = (F.tid >> 4) & 7, d4 = F.tid & 15; f32x4 vr[16];
#pragma unroll
    for (int i = 0; i < 16; ++i) { const int j = jq * 16 + i; if (j < 127) vr[i] = __builtin_nontemporal_load((const f32x4*)(cv + (j + 1) * 256 + vkvh * 64 + d4 * 4)); else vr[i] = *(const LAS f32x4*)(vn + vkvh * 64 + d4 * 4); }
    __syncthreads();
    for (int hh = 0; hh < 3; ++hh) { const int head = F.wave * 3 + hh; const float sink = F.in[10][head];
        const float s0 = sc[head * 128 + F.lane], s1 = sc[head * 128 + 64 + F.lane];
        const float mx = fmaxf(wave_max(fmaxf(s0, s1)), sink); const float p0 = __expf(s0 - mx), p1 = __expf(s1 - mx);
        const float sum = wave_sum(p0 + p1); sc[head * 128 + F.lane] = p0; sc[head * 128 + 64 + F.lane] = p1;
        if (F.lane == 0) pinv[head] = 1.f / (sum + __expf(sink - mx)); }
    __syncthreads();
    { f32x4 oa[6];
#pragma unroll
      for (int g = 0; g < 6; ++g) oa[g] = (f32x4){0.f, 0.f, 0.f, 0.f};
#pragma unroll
      for (int i = 0; i < 16; ++i) { const int j = jq * 16 + i; __builtin_nontemporal_store(vr[i], (f32x4*)(ov + j * 256 + vkvh * 64 + d4 * 4));
#pragma unroll
          for (int g = 0; g < 6; ++g) oa[g] += vr[i] * sc[(vkvh * 6 + g) * 128 + j]; }
#pragma unroll
      for (int g = 0; g < 6; ++g) *(LAS f32x4*)(red + (jq * 24 + vkvh * 6 + g) * 64 + d4 * 4) = oa[g]; }
    __syncthreads();
    for (int i = F.tid; i < 1536; i += 512) { const int head = i >> 6, d = i & 63; float o = 0.f;
#pragma unroll
        for (int q8 = 0; q8 < 8; ++q8) o += red[(q8 * 24 + head) * 64 + d];
        const float g = bf2f(U0[row * N0 + 2560 + i]);
        BR[row * DM + i] = f2bf(o * pinv[head] * silu_f(g)); }
}
__device__ __forceinline__ void mem_sample_unit(Frame& F, int layer, int b, int h, const bf16* U, int ldu, int mq_col0, int gate_col0) {
    bf16* BR = (bf16*)(F.ws + WS_BR);
    LAS float* sc = (LAS float*)(F.lds + 73728 + 32768);
    LAS float* red = sc + 256;
    const size_t row = (size_t)(ROW_S + b);
    const float* mk = F.in[2] + ((size_t)layer * NDEC + b) * (256 * 512) + h * 128; const float* mv = F.in[3] + ((size_t)layer * NDEC + b) * (256 * 512) + h * 128;
    const int half = F.lane >> 5, l32 = F.lane & 31, w = F.wave;
    const v2u qraw = *(const v2u*)(U + row * ldu + mq_col0 + h * 128 + l32 * 4);
    unsigned short graw = 0; if (F.tid < 128) graw = U[row * ldu + gate_col0 + 1536 + h * 128 + F.tid];
    f32x4 kv[16];
#pragma unroll
    for (int i = 0; i < 16; ++i) kv[i] = __builtin_nontemporal_load((const f32x4*)(mk + (size_t)(32 * w + 2 * i + half) * 512 + l32 * 4));
    __syncthreads();
    { const float sc0 = 0.08838834764831845f;
      const f32x4 qq = (f32x4){__uint_as_float(qraw.x << 16), __uint_as_float(qraw.x & 0xffff0000u), __uint_as_float(qraw.y << 16), __uint_as_float(qraw.y & 0xffff0000u)} * sc0;
#pragma unroll
      for (int i = 0; i < 16; ++i) { float p = kv[i].x * qq.x + kv[i].y * qq.y + kv[i].z * qq.z + kv[i].w * qq.w;
          p += __shfl_xor(p, 1); p += __shfl_xor(p, 2); p += __shfl_xor(p, 4); p += __shfl_xor(p, 8); p += __shfl_xor(p, 16);
          if (l32 == 0) sc[32 * w + 2 * i + half] = p; } }
    f32x4 vv[16];
#pragma unroll
    for (int i = 0; i < 16; ++i) vv[i] = __builtin_nontemporal_load((const f32x4*)(mv + (size_t)(32 * w + 2 * i + half) * 512 + l32 * 4));
    __syncthreads();
    if (w == 0) { float s[4]; float mx = -INFINITY;
#pragma unroll
        for (int i = 0; i < 4; ++i) { s[i] = sc[64 * i + F.lane]; mx = fmaxf(mx, s[i]); }
        mx = wave_max(mx); float sum = 0.f;
#pragma unroll
        for (int i = 0; i < 4; ++i) { s[i] = __expf(s[i] - mx); sum += s[i]; }
        sum = wave_sum(sum); const float inv = 1.f / sum;
#pragma unroll
        for (int i = 0; i < 4; ++i) sc[64 * i + F.lane] = s[i] * inv; }
    __syncthreads();
    { f32x4 o4 = {0.f, 0.f, 0.f, 0.f};
#pragma unroll
      for (int i = 0; i < 16; ++i) o4 += vv[i] * sc[32 * w + 2 * i + half];
      o4.x += __shfl_xor(o4.x, 32); o4.y += __shfl_xor(o4.y, 32); o4.z += __shfl_xor(o4.z, 32); o4.w += __shfl_xor(o4.w, 32);
      if (half == 0) *(LAS f32x4*)(red + w * 128 + l32 * 4) = o4; }
    __syncthreads();
    if (F.tid < 128) { float o = 0.f;
#pragma unroll
        for (int i = 0; i < 8; ++i) o += red[i * 128 + F.tid];
        BR[row * DM + 1536 + h * 128 + F.tid] = f2bf(o * silu_f(bf2f(graw))); }
}
__device__ __forceinline__ void hgrn_sample_unit(Frame& F, int b, int h) {
    const bf16* U1 = (const bf16*)(F.ws + WS_U1); bf16* BR = (bf16*)(F.ws + WS_BR);
    LAS float* qs = (LAS float*)(F.lds + 73728 + 49152);
    LAS float* fk = qs + 128; LAS float* kk = fk + 128; LAS float* vv = kk + 128; LAS float* red = vv + 128;
    LAS float* tot = red + 2048;
    const size_t row = (size_t)(ROW_S + b);
    const float* S0 = F.in[6] + ((size_t)b * 12 + h) * 16384; float* So = F.out + O_HSS + ((size_t)b * 12 + h) * 16384;
    const int c4 = F.tid & 31, kr = F.tid >> 5;
    f32x4 s4[8];
#pragma unroll
    for (int i = 0; i < 8; ++i) s4[i] = __builtin_nontemporal_load((const f32x4*)(S0 + (kr + 16 * i) * 128 + c4 * 4));
    unsigned short graw = 0, qraw = 0, fraw = 0, vraw = 0;
    if (F.tid < 128) { graw = U1[row * N1 + 5120 + h * 128 + F.tid]; qraw = U1[row * N1 + h * 128 + F.tid]; fraw = U1[row * N1 + 1536 + h * 128 + F.tid]; }
    else if (F.tid < 256) vraw = U1[row * N1 + 3072 + h * 128 + F.tid - 128];
    __syncthreads();
    if (F.tid < 128) { const int k = F.tid; const float l0 = F.in[12][h * 128 + k], l1 = F.in[12][1536 + h * 128 + k]; const float lb = fast_rcp(1.f + __expf(l0 - l1));
        const float fg = lb + (1.f - lb) * sigmoid_f(bf2f(fraw)); qs[k] = silu_f(bf2f(qraw)); fk[k] = fg; kk[k] = 1.f - fg; }
    else if (F.tid < 256) vv[F.tid - 128] = bf2f(vraw);
    __syncthreads();
    { const f32x4 v4 = *(const LAS f32x4*)(vv + c4 * 4); f32x4 o4 = {0.f, 0.f, 0.f, 0.f};
#pragma unroll
      for (int i = 0; i < 8; ++i) { const int k = kr + 16 * i; const f32x4 sn = s4[i] * fk[k] + v4 * kk[k];
          __builtin_nontemporal_store(sn, (f32x4*)(So + k * 128 + c4 * 4)); o4 += sn * qs[k]; }
      *(LAS f32x4*)(red + kr * 128 + c4 * 4) = o4; }
    __syncthreads();
    float o = 0.f;
    if (F.tid < 128) {
#pragma unroll
        for (int i = 0; i < 16; ++i) o += red[i * 128 + F.tid];
        const float ss = wave_sum(o * o); if (F.lane == 0) tot[F.wave] = ss; }
    __syncthreads();
    if (F.tid < 128) { const float rstd = 1.f / sqrtf((tot[0] + tot[1]) * (1.f / 128.f) + 1e-6f); const int c = h * 128 + F.tid;
        BR[row * DM + c] = f2bf(o * rstd * F.in[13][c] * silu_f(bf2f(graw))); }
}

constexpr int HG_REC = 41472, HGR_QG = 0, HGR_KDT = 16384, HGR_AS = 32768, HGR_EGL = 40960;
constexpr int HG_QG = 0, HG_QT = 17408, HG_KT = 34816, HG_VS = 52224, HG_KDT = 69632, HG_AS = 88064, HG_SEG = 97280, HG_EGL = 99328, HG_PART = 99840;
__device__ __forceinline__ float row16_sum(float v) {
    int x = __builtin_bit_cast(int, v);
    v += __builtin_bit_cast(float, __builtin_amdgcn_update_dpp(0, x, 0xB1, 0xF, 0xF, false)); x = __builtin_bit_cast(int, v);
    v += __builtin_bit_cast(float, __builtin_amdgcn_update_dpp(0, x, 0x4E, 0xF, 0xF, false)); x = __builtin_bit_cast(int, v);
    v += __builtin_bit_cast(float, __builtin_amdgcn_update_dpp(0, x, 0x141, 0xF, 0xF, false)); x = __builtin_bit_cast(int, v);
    v += __builtin_bit_cast(float, __builtin_amdgcn_update_dpp(0, x, 0x140, 0xF, 0xF, false));
    return v;
}
__device__ __forceinline__ void hgrn_prep_phase(Frame& F) {
    const bf16* U1 = (const bf16*)(F.ws + WS_U1); unsigned char* HG = F.ws + WS_HG;
    LAS unsigned char* L = F.lds; LAS float* SEG = (LAS float*)(L + HG_SEG);
    const int tid = F.tid, lane = F.lane, w = F.wave, fr = lane & 15, fq = lane >> 4;
    const int k = tid & 127, tq = tid >> 7;
    const float L2E = 1.4426950408889634f;
    unsigned short nqr[16], nfr[16];
#define HGP_LOAD(id_) do { const int bh_ = (id_) >> 5, c_ = (id_) & 31, b_ = bh_ / 12, h_ = bh_ % 12; const size_t r0_ = (size_t)b_ * SEQ + c_ * 64 + tq * 16; \
        _Pragma("unroll") for (int i = 0; i < 16; ++i) { nqr[i] = __builtin_nontemporal_load(U1 + (r0_ + i) * N1 + h_ * 128 + k); nfr[i] = __builtin_nontemporal_load(U1 + (r0_ + i) * N1 + 1536 + h_ * 128 + k); } } while (0)
    int id = F.bid;
    if (id < NB * 12 * 32) HGP_LOAD(id);
    __syncthreads();
#pragma unroll 1
    for (; id < NB * 12 * 32; id += F.G) {
        const int bh = id >> 5, h = bh % 12;
        unsigned char* rec = HG + (size_t)id * HG_REC;
        float lbk; { const float l0 = F.in[12][h * 128 + k], l1 = F.in[12][1536 + h * 128 + k]; lbk = fast_rcp(1.f + __expf(l0 - l1)); }
        const float oml = 1.f - lbk;
        float gl[16], qv[16], kv[16]; float run = 0.f;
#pragma unroll
        for (int i = 0; i < 16; ++i) { const float f = bf2f(nfr[i]), q = bf2f(nqr[i]);
            const float sg = fast_rcp(1.f + __builtin_amdgcn_exp2f(-L2E * f)); const float fg = __builtin_fmaf(sg, oml, lbk);
            run += __builtin_amdgcn_logf(fg); gl[i] = run; kv[i] = 1.f - fg; qv[i] = q * fast_rcp(1.f + __builtin_amdgcn_exp2f(-L2E * q)); }
        SEG[tq * 128 + k] = run;
        if (id + F.G < NB * 12 * 32) HGP_LOAD(id + F.G);
        LDS_BARRIER();
        const float s0 = SEG[k], s1 = SEG[128 + k], s2 = SEG[256 + k], s3 = SEG[384 + k];
        const float gmid = s0 + s1, glast = gmid + s2 + s3;
        const float basem = ((tq == 0) ? 0.f : (tq == 1) ? s0 : (tq == 2) ? gmid : gmid + s2) - gmid;
        const float egm = __builtin_amdgcn_exp2f(gmid), eglm = __builtin_amdgcn_exp2f(glast - gmid);
        if (tq == 0) *(float*)(rec + HGR_EGL + 4 * k) = __builtin_amdgcn_exp2f(glast);
        { unsigned kd[8];
#pragma unroll
          for (int i = 0; i < 16; ++i) { const int t = tq * 16 + i; const float x = __builtin_amdgcn_fmed3f(basem + gl[i], -115.f, 115.f);
              const float e1 = __builtin_amdgcn_exp2f(x), e2 = fast_rcp(e1); const float qt = qv[i] * e1, kt = kv[i] * e2;
              const unsigned pq = pk2(qt, qt * egm);
              *(LAS unsigned short*)(L + HG_QT + t * 272 + k * 2) = (unsigned short)(pq & 0xffffu);
              *(LAS unsigned short*)(L + HG_QG + t * 272 + k * 2) = (unsigned short)(pq >> 16);
              const unsigned pkk = pk2(kt, kt * eglm);
              *(LAS unsigned short*)(L + HG_KT + t * 272 + k * 2) = (unsigned short)(pkk & 0xffffu);
              if (i & 1) kd[i >> 1] |= (pkk & 0xffff0000u); else kd[i >> 1] = pkk >> 16; }
          *(LAS v4u*)(L + HG_KDT + k * 144 + tq * 32) = (v4u){kd[0], kd[1], kd[2], kd[3]};
          *(LAS v4u*)(L + HG_KDT + k * 144 + tq * 32 + 16) = (v4u){kd[4], kd[5], kd[6], kd[7]}; }
        LDS_BARRIER();
#pragma unroll
        for (int jj = 0; jj < 2; ++jj) { const int tile = 2 * w + jj, tt = tile >> 2, ts = tile & 3; f32x4 a = {0.f, 0.f, 0.f, 0.f};
            if (ts <= tt) {
#pragma unroll
                for (int ks = 0; ks < 4; ++ks) { const bf16x8 af = *(const LAS bf16x8*)(L + HG_QT + (16 * tt + fr) * 272 + (32 * ks + 8 * fq) * 2);
                    const bf16x8 bfv = *(const LAS bf16x8*)(L + HG_KT + (16 * ts + fr) * 272 + (32 * ks + 8 * fq) * 2);
                    a = __builtin_amdgcn_mfma_f32_16x16x32_bf16(af, bfv, a, 0, 0, 0); } }
#pragma unroll
            for (int r = 0; r < 4; ++r) { const int t = 16 * tt + 4 * fq + r, s = 16 * ts + fr; const float v = (ts <= tt && s <= t) ? a[r] : 0.f;
                *(LAS unsigned short*)(L + HG_AS + t * 144 + s * 2) = f2bf(v); } }
        LDS_BARRIER();
#pragma unroll
        for (int i = 0; i < 2; ++i) { const int p = tid + 512 * i; *(v4u*)(rec + HGR_QG + p * 16) = *(const LAS v4u*)(L + HG_QG + (p >> 4) * 272 + (p & 15) * 16); }
#pragma unroll
        for (int i = 0; i < 2; ++i) { const int p = tid + 512 * i; *(v4u*)(rec + HGR_KDT + p * 16) = *(const LAS v4u*)(L + HG_KDT + (p >> 3) * 144 + (p & 7) * 16); }
        { const int p = tid; *(v4u*)(rec + HGR_AS + p * 16) = *(const LAS v4u*)(L + HG_AS + (p >> 3) * 144 + (p & 7) * 16); }
        LDS_BARRIER();
    }
#undef HGP_LOAD
}
constexpr int HG_GT = 101888;
struct HgStage { v4u st[9]; f32x4 egl; };
__device__ __forceinline__ void hgs_load(HgStage& S, const unsigned char* HG, const bf16* U1, int b, int h, int cc, int tid) {
    typedef const __attribute__((address_space(1))) unsigned char* gp;
    gp rec = (gp)(HG + (size_t)cc * HG_REC); gp vb = (gp)(U1 + ((size_t)b * SEQ + cc * 64) * N1 + 3072 + h * 128);
    const unsigned o16 = (unsigned)tid * 16u, ov = ((unsigned)(tid >> 4) * N1 + (unsigned)(tid & 15) * 8u) * 2u;
    typedef const __attribute__((address_space(1))) v4u* g4; typedef const __attribute__((address_space(1))) f32x4* gf4;
    S.st[0] = __builtin_nontemporal_load((g4)(rec + HGR_QG + o16)); S.st[1] = __builtin_nontemporal_load((g4)(rec + HGR_QG + 8192 + o16));
    S.st[2] = __builtin_nontemporal_load((g4)(rec + HGR_KDT + o16)); S.st[3] = __builtin_nontemporal_load((g4)(rec + HGR_KDT + 8192 + o16));
    S.st[4] = __builtin_nontemporal_load((g4)(rec + HGR_AS + o16));
    S.st[5] = __builtin_nontemporal_load((g4)(vb + ov)); S.st[6] = __builtin_nontemporal_load((g4)(vb + (size_t)32 * N1 * 2 + ov));
    S.st[7] = __builtin_nontemporal_load((g4)(vb + 2048 * 2 + ov)); S.st[8] = __builtin_nontemporal_load((g4)(vb + (size_t)32 * N1 * 2 + 2048 * 2 + ov));
    if (tid < 32) S.egl = *(gf4)(rec + HGR_EGL + o16);
}
__device__ __forceinline__ void hgs_stage(const HgStage& S, LAS unsigned char* L, int tid) {
    const int r = tid >> 4, ch = tid & 15, r8 = tid >> 3, c8 = tid & 7;
    *(LAS v4u*)(L + HG_QG + r * 272 + ch * 16) = S.st[0]; *(LAS v4u*)(L + HG_QG + (32 + r) * 272 + ch * 16) = S.st[1];
    *(LAS v4u*)(L + HG_KDT + r8 * 144 + c8 * 16) = S.st[2]; *(LAS v4u*)(L + HG_KDT + (64 + r8) * 144 + c8 * 16) = S.st[3];
    *(LAS v4u*)(L + HG_AS + r8 * 144 + c8 * 16) = S.st[4];
    *(LAS v4u*)(L + HG_VS + r * 272 + ch * 16) = S.st[5]; *(LAS v4u*)(L + HG_VS + (32 + r) * 272 + ch * 16) = S.st[6];
    *(LAS v4u*)(L + HG_GT + r * 272 + ch * 16) = S.st[7]; *(LAS v4u*)(L + HG_GT + (32 + r) * 272 + ch * 16) = S.st[8];
    if (tid < 32) *(LAS f32x4*)(L + HG_EGL + tid * 16) = S.egl;
}
constexpr int HG_RSTD = 119296;
constexpr int HG_PART2 = 119552;
__device__ __forceinline__ void hgs_compute(f32x4 (&Sacc)[8], LAS unsigned char* L, v2u (&pend)[4], const f32x4 nw4, int tid, int w, int fr, int fq) {
    LAS float* EGL = (LAS float*)(L + HG_EGL); LAS float* PART = (LAS float*)(L + HG_PART2); LAS float* RSTD = (LAS float*)(L + HG_RSTD); const int dv0 = 16 * w;
#define SB() __builtin_amdgcn_sched_barrier(0)
    bf16x8 vf[2]; f32x4 o[4];
    { bf16x8 as[4][2];
#pragma unroll
      for (int ks = 0; ks < 2; ++ks) { const LAS unsigned char* vp = L + HG_VS + (32 * ks + 8 * fq + (fr >> 2)) * 272 + (dv0 + 4 * (fr & 3)) * 2;
          const s16x4 lo = vtr(vp), hi = vtr(vp + 4 * 272); vf[ks] = (bf16x8){lo[0], lo[1], lo[2], lo[3], hi[0], hi[1], hi[2], hi[3]}; }
#pragma unroll
      for (int tt = 0; tt < 4; ++tt)
#pragma unroll
          for (int ks = 0; ks < 2; ++ks) as[tt][ks] = *(const LAS bf16x8*)(L + HG_AS + (16 * tt + fr) * 144 + (32 * ks + 8 * fq) * 2);
      SB();
#pragma unroll
      for (int tt = 0; tt < 4; ++tt) { o[tt] = (f32x4){0.f, 0.f, 0.f, 0.f};
#pragma unroll
          for (int ks = 0; ks < 2; ++ks) o[tt] = __builtin_amdgcn_mfma_f32_16x16x32_bf16(vf[ks], as[tt][ks], o[tt], 0, 0, 0); }
      SB(); }
    bf16x8 sb[4];
#pragma unroll
    for (int mm = 0; mm < 4; ++mm) { v4u wv; wv.x = pk2(Sacc[2 * mm][0], Sacc[2 * mm][1]); wv.y = pk2(Sacc[2 * mm][2], Sacc[2 * mm][3]);
        wv.z = pk2(Sacc[2 * mm + 1][0], Sacc[2 * mm + 1][1]); wv.w = pk2(Sacc[2 * mm + 1][2], Sacc[2 * mm + 1][3]); sb[mm] = __builtin_bit_cast(bf16x8, wv); }
#pragma unroll
    for (int hh = 0; hh < 2; ++hh) { v2u qa[2][4][2];
#pragma unroll
        for (int t2 = 0; t2 < 2; ++t2)
#pragma unroll
            for (int mm = 0; mm < 4; ++mm) { const LAS unsigned char* qp = L + HG_QG + (16 * (2 * hh + t2) + fr) * 272 + (32 * mm + 4 * fq) * 2; qa[t2][mm][0] = *(const LAS v2u*)qp; qa[t2][mm][1] = *(const LAS v2u*)(qp + 32); }
        SB();
#pragma unroll
        for (int t2 = 0; t2 < 2; ++t2)
#pragma unroll
            for (int mm = 0; mm < 4; ++mm) o[2 * hh + t2] = __builtin_amdgcn_mfma_f32_16x16x32_bf16(sb[mm], __builtin_bit_cast(bf16x8, (v4u){qa[t2][mm][0].x, qa[t2][mm][0].y, qa[t2][mm][1].x, qa[t2][mm][1].y}), o[2 * hh + t2], 0, 0, 0);
        SB(); }
#pragma unroll
    for (int hh = 0; hh < 2; ++hh) { bf16x8 ka[4][2]; f32x4 ega[4];
#pragma unroll
        for (int T = 0; T < 4; ++T) { ega[T] = *(const LAS f32x4*)(EGL + 16 * (4 * hh + T) + 4 * fq);
#pragma unroll
            for (int ks = 0; ks < 2; ++ks) ka[T][ks] = *(const LAS bf16x8*)(L + HG_KDT + (16 * (4 * hh + T) + fr) * 144 + (32 * ks + 8 * fq) * 2); }
        SB();
#pragma unroll
        for (int T = 0; T < 4; ++T) { f32x4 acc = Sacc[4 * hh + T] * ega[T];
#pragma unroll
            for (int ks = 0; ks < 2; ++ks) acc = __builtin_amdgcn_mfma_f32_16x16x32_bf16(ka[T][ks], vf[ks], acc, 0, 0, 0);
            Sacc[4 * hh + T] = acc; }
        SB(); }
#undef SB
#pragma unroll
    for (int tt = 0; tt < 4; ++tt) { const f32x4 q = o[tt] * o[tt]; PART[(16 * tt + fr) * 32 + 4 * w + fq] = (q.x + q.y) + (q.z + q.w); }
    LDS_BARRIER();
    { const int t = tid >> 3, j = tid & 7; const f32x4 p = *(const LAS f32x4*)(PART + t * 32 + 4 * j); float s = (p.x + p.y) + (p.z + p.w);
      int x = __builtin_bit_cast(int, s);
      s += __builtin_bit_cast(float, __builtin_amdgcn_update_dpp(0, x, 0xB1, 0xF, 0xF, false)); x = __builtin_bit_cast(int, s);
      s += __builtin_bit_cast(float, __builtin_amdgcn_update_dpp(0, x, 0x4E, 0xF, 0xF, false)); x = __builtin_bit_cast(int, s);
      s += __builtin_bit_cast(float, __builtin_amdgcn_update_dpp(0, x, 0x141, 0xF, 0xF, false));
      if (j == 0) RSTD[t] = __builtin_amdgcn_rsqf(s * (1.f / 128.f) + 1e-6f); }
    LDS_BARRIER();
#pragma unroll
    for (int tt = 0; tt < 4; ++tt) { const int t = 16 * tt + fr; const float rstd = RSTD[t]; const v2u g2 = *(const LAS v2u*)(L + HG_GT + t * 272 + (dv0 + 4 * fq) * 2);
        const float g0 = __uint_as_float(g2.x << 16), g1 = __uint_as_float(g2.x & 0xffff0000u), g2f = __uint_as_float(g2.y << 16), g3 = __uint_as_float(g2.y & 0xffff0000u);
        const f32x4 y = o[tt] * rstd * nw4;
        pend[tt].x = pk2(y.x * silu_f(g0), y.y * silu_f(g1)); pend[tt].y = pk2(y.z * silu_f(g2f), y.w * silu_f(g3)); }
    LDS_BARRIER();
}
__device__ __forceinline__ void hgrn_seq_unit(Frame& F, int b, int h, int vflags) {
    const bf16* U1 = (const bf16*)(F.ws + WS_U1); bf16* BR = (bf16*)(F.ws + WS_BR); const unsigned char* HG = F.ws + WS_HG + (size_t)(b * 12 + h) * 32 * HG_REC;
    LAS unsigned char* L = F.lds;
    const int tid = F.tid, lane = F.lane, w = F.wave, fr = lane & 15, fq = lane >> 4;
    const f32x4 nw4 = *(const f32x4*)(F.in[13] + h * 128 + 16 * w + 4 * fq);
    f32x4 Sacc[8];
#pragma unroll
    for (int T = 0; T < 8; ++T) Sacc[T] = (f32x4){0.f, 0.f, 0.f, 0.f};
    HgStage SA, SB; SA.egl = SB.egl = (f32x4){0.f, 0.f, 0.f, 0.f};
    v2u pend[4];
#pragma unroll
    for (int i = 0; i < 4; ++i) pend[i] = (v2u){0u, 0u};
    hgs_load(SA, HG, U1, b, h, 0, tid); hgs_load(SB, HG, U1, b, h, 1, tid);
    __syncthreads();
#define HGS_STORE(cc) do { bf16* op_ = BR + ((size_t)b * SEQ + (cc) * 64 + fr) * DM + h * 128 + 16 * w + 4 * fq; \
        _Pragma("unroll") for (int tt = 0; tt < 4; ++tt) *(v2u*)(op_ + (size_t)(16 * tt) * DM) = pend[tt]; } while (0)
#define HGS_STEP(S, cc) do { if (!(vflags & 512)) hgs_stage(S, L, tid); asm volatile("" ::: "memory"); \
        if ((cc) > 0 && !(vflags & 128)) HGS_STORE((cc) - 1); asm volatile("" ::: "memory"); \
        if ((cc) + 2 < 32 && !(vflags & 64)) hgs_load(S, HG, U1, b, h, (cc) + 2, tid); \
        LDS_BARRIER(); if (!(vflags & 256)) hgs_compute(Sacc, L, pend, nw4, tid, w, fr, fq); } while (0)
#pragma unroll 1
    for (int c = 0; c < 32; c += 2) { HGS_STEP(SA, c); HGS_STEP(SB, c + 1); }
#undef HGS_STEP
    HGS_STORE(31);
#undef HGS_STORE
    float* So = F.out + O_HSP + ((size_t)b * 12 + h) * 16384;
#pragma unroll
    for (int T = 0; T < 8; ++T)
#pragma unroll
        for (int r = 0; r < 4; ++r) __builtin_nontemporal_store(Sacc[T][r], So + (16 * T + 4 * fq + r) * 128 + 16 * w + fr);
}

struct SkStoreProj { bf16* U; int ldu;
    __device__ __forceinline__ void operator()(int row, int col, f32x4 v) const { v2u o; o.x = pk2(v.x, v.y); o.y = pk2(v.z, v.w); *(v2u*)(U + (size_t)(ROW_S + row) * ldu + col) = o; } };
struct SkStoreOut { bf16* Z; int mode; const bf16* xb; const bf16* zprev; const float* stats; const float* lnw; const float* lnb;
    __device__ __forceinline__ void operator()(int row, int col, f32x4 v) const { const size_t ro = (size_t)(ROW_S + row) * DM + col; const v2u q = *(const v2u*)((mode == 0 ? xb : zprev) + ro);
        f32x4 r = (f32x4){__uint_as_float(q.x << 16), __uint_as_float(q.x & 0xffff0000u), __uint_as_float(q.y << 16), __uint_as_float(q.y & 0xffff0000u)};
        if (mode == 1) { const float mu = stats[2 * (ROW_S + row)], rs = stats[2 * (ROW_S + row) + 1]; r = (r - mu) * rs * *(const f32x4*)(lnw + col) + *(const f32x4*)(lnb + col); }
        const f32x4 y = r * ALPHA + v; v2u o; o.x = pk2(y.x, y.y); o.y = pk2(y.z, y.w); *(v2u*)(Z + ro) = o; } };
template <class Store>
__device__ __forceinline__ void skinny_unit(Frame& F, const bf16* A, const bf16* Bt, int n0, const Store& st) {
    const int lane = F.lane, fr = lane & 15, fq = lane >> 4, w = F.wave;
    f32x4 acc[8][2];
#pragma unroll
    for (int m = 0; m < 8; ++m) { acc[m][0] = (f32x4){0.f, 0.f, 0.f, 0.f}; acc[m][1] = (f32x4){0.f, 0.f, 0.f, 0.f}; }
    const bf16* ap = A + (size_t)fr * DM + 256 * w + 8 * fq; const bf16* bp = Bt + (size_t)(n0 + fr) * DM + 256 * w + 8 * fq;
#pragma unroll 4
    for (int ks = 0; ks < 8; ++ks) { bf16x8 bfr[2], afr[8];
#pragma unroll
        for (int n = 0; n < 2; ++n) bfr[n] = *(const bf16x8*)(bp + (size_t)n * 16 * DM + ks * 32);
#pragma unroll
        for (int m = 0; m < 8; ++m) afr[m] = *(const bf16x8*)(ap + (size_t)m * 16 * DM + ks * 32);
#pragma unroll
        for (int m = 0; m < 8; ++m)
#pragma unroll
            for (int n = 0; n < 2; ++n) acc[m][n] = __builtin_amdgcn_mfma_f32_16x16x32_bf16(bfr[n], afr[m], acc[m][n], 0, 0, 0); }
    LAS f32x4* red = (LAS f32x4*)F.lds;
    __syncthreads();
#pragma unroll
    for (int m = 0; m < 8; ++m)
#pragma unroll
        for (int n = 0; n < 2; ++n) red[(w * 16 + m * 2 + n) * 64 + lane] = acc[m][n];
    __syncthreads();
#pragma unroll
    for (int n = 0; n < 2; ++n) { f32x4 s = {0.f, 0.f, 0.f, 0.f};
#pragma unroll
        for (int ww = 0; ww < 8; ++ww) s += red[(ww * 16 + w * 2 + n) * 64 + lane];
        st(16 * w + fr, n0 + 16 * n + 4 * fq, s); }
}
template <class Store>
__device__ __forceinline__ void skinny_phase(Frame& F, const bf16* A, const bf16* Bt, int N, int span, const Store& st) {
    if (span > F.G) span = F.G;
    const int first = F.G - 1 - F.bid; if (first >= span) return;
    for (int u = first; u < N / 32; u += span) skinny_unit(F, A, Bt, 32 * u, st);
}

#define XB_TMO      128
#define XB_XCNT(j)  (256  + 64 * (j))
#define XB_XSUB(j)  (1280 + 64 * (j))
#define XB_XGEN(j)  (2304 + 64 * (j))
#define XB_TOP      3328
#define XB_TOPGEN   3392
#define XCD_BAR_WORDS 3456
#define XB_SPIN_CAP (1u << 18)

__device__ __forceinline__ unsigned xb_ld(unsigned* p)              { return __hip_atomic_load(p, __ATOMIC_RELAXED, __HIP_MEMORY_SCOPE_AGENT); }
__device__ __forceinline__ unsigned xb_add(unsigned* p, unsigned v) { return __hip_atomic_fetch_add(p, v, __ATOMIC_RELAXED, __HIP_MEMORY_SCOPE_AGENT); }
__device__ __forceinline__ unsigned xb_xcc_id() { return (unsigned)__builtin_amdgcn_s_getreg((3 << 11) | 20) & 0xFu; }
#define XB_SPIN(cond, bar) do { unsigned _sp = 0; while (cond) { __builtin_amdgcn_s_sleep(1); \
    if ((++_sp & 255u) == 0u) { if (xb_ld(&(bar)[XB_TMO])) break; if (_sp > XB_SPIN_CAP) { atomicAdd(&(bar)[XB_TMO], 1u); break; } } } } while (0)

struct XcdBarrier {
    unsigned* bar; unsigned x;
    volatile LAS unsigned* st;
};

__device__ __forceinline__ XcdBarrier xcd_barrier_post(unsigned* bar, volatile LAS unsigned* st) {
    XcdBarrier b; b.bar = bar; b.x = xb_xcc_id(); b.st = st;
    if (threadIdx.x == 0) (void)xb_add(&bar[XB_XCNT(b.x)], 1u);
    return b;
}
__device__ __forceinline__ void xcd_barrier_complete(unsigned* bar, unsigned x, unsigned& nloc, unsigned& nx) {
    const unsigned G = gridDim.x * gridDim.y * gridDim.z;
    unsigned sum, cnt, mine, sp = 0u;
    for (;;) {
        sum = 0u; cnt = 0u; mine = 0u;
#pragma unroll
        for (unsigned j = 0; j < 16; ++j) { const unsigned c = xb_ld(&bar[XB_XCNT(j)]); sum += c; cnt += (c > 0u) ? 1u : 0u; mine = (j == x) ? c : mine; }
        if (sum == G) break;
        __builtin_amdgcn_s_sleep(1);
        if ((++sp & 255u) == 0u) { if (xb_ld(&bar[XB_TMO])) break; if (sp > XB_SPIN_CAP) { atomicAdd(&bar[XB_TMO], 1u); break; } }
    }
    nloc = mine > 0u ? mine : 1u; nx = cnt > 0u ? cnt : 1u;
}

__device__ __forceinline__ void xcd_barrier(const XcdBarrier& b) {
    asm volatile("s_waitcnt vmcnt(0)" ::: "memory");
    __syncthreads();
    if (threadIdx.x == 0) {
        unsigned* bar = b.bar;
        __builtin_amdgcn_s_waitcnt(0);
        unsigned nloc = b.st[0], nx = b.st[1];
        if (nloc == 0u) { xcd_barrier_complete(bar, b.x, nloc, nx); b.st[0] = nloc; b.st[1] = nx; }
        const unsigned old = xb_add(&bar[XB_XSUB(b.x)], 1u);
        const unsigned gen = old / nloc;
        if (old + 1u == (gen + 1u) * nloc) {
            __builtin_amdgcn_fence(__ATOMIC_RELEASE, "agent");
            asm volatile("s_waitcnt vmcnt(0)" ::: "memory");
            const unsigned og = xb_add(&bar[XB_TOP], 1u);
            const unsigned tg = og / nx;
            if (og + 1u == (tg + 1u) * nx) xb_add(&bar[XB_TOPGEN], 1u);
            else XB_SPIN(xb_ld(&bar[XB_TOPGEN]) == tg, bar);
            __builtin_amdgcn_fence(__ATOMIC_ACQUIRE, "agent");
            xb_add(&bar[XB_XGEN(b.x)], 1u);
            asm volatile("s_waitcnt vmcnt(0)" ::: "memory");
        } else {
            XB_SPIN(xb_ld(&bar[XB_XGEN(b.x)]) == gen, bar);
            __builtin_amdgcn_fence(__ATOMIC_ACQUIRE, "agent");
            asm volatile("s_waitcnt vmcnt(0)" ::: "memory");
        }
    }
    __syncthreads();
}

constexpr int LDS_MISC = LDS_BYTES - 256;
constexpr size_t CTL_ZERO_BYTES = 262144;
struct Args { const float* in[19]; float* out; unsigned char* ws; int ph_lo, ph_hi, li, flags; };
constexpr int N_PHASES = 10;
#ifndef MK_PLAN
#define MK_PLAN 0
#endif

__global__ void __launch_bounds__(512, 2) fwd_megakernel(Args args) {
    extern __shared__ __attribute__((aligned(16))) unsigned char lds_raw[];
    Frame F;
    F.lds = (LAS unsigned char*)lds_raw;
    F.tid = threadIdx.x; F.lane = F.tid & 63; F.wave = __builtin_amdgcn_readfirstlane(F.tid >> 6);
    F.G = gridDim.x; F.bid = blockIdx.x;
#pragma unroll
    for (int i = 0; i < 19; ++i) F.in[i] = args.in[i];
    F.out = args.out; F.ws = args.ws;
    const int lo = args.ph_lo, hi = args.ph_hi, fl = args.flags;
    if (F.tid < 64) ((LAS unsigned*)(F.lds + LDS_MISC))[F.tid] = 0u;
    __syncthreads();
    XcdBarrier bar = xcd_barrier_post((unsigned*)(F.ws + WS_CTL) + 1024 + args.li * 4096, (volatile LAS unsigned*)(F.lds + LDS_MISC));
#define IN(k) (lo <= (k) && (k) < hi)
#define SEAM(k) do { if (IN(k) && IN((k) + 1)) { xcd_barrier(bar); } } while (0)
    const int gw = F.bid * 8 + F.wave, NGW = F.G * 8;
    bf16* A0 = (bf16*)(F.ws + WS_A0); bf16* U0 = (bf16*)(F.ws + WS_U0); bf16* U1 = (bf16*)(F.ws + WS_U1); bf16* BR = (bf16*)(F.ws + WS_BR);
    bf16* H1 = (bf16*)(F.ws + WS_H1); bf16* Z0 = (bf16*)(F.ws + WS_Z0); bf16* Z1 = (bf16*)(F.ws + WS_Z1); float* STATS = (float*)(F.ws + WS_MISC);
    bf16* WT0 = (bf16*)(F.ws + WS_WT0); bf16* WT1 = (bf16*)(F.ws + WS_WT1); bf16* WO = (bf16*)(F.ws + WS_WO); bf16* MKVB = (bf16*)(F.ws + WS_MKVB);

    if (IN(0)) { p0_prologue(F); }
    SEAM(0);
    if (IN(1)) {
        pg8::Gemm g{A0, WT0, A0_ROWS, N0 + 2048, DM};
        pg8::OrderExt S; S.init(NTOK, N0, F.G, F.bid, 64, ROWS_ACT / 256, N0 / 256, 8);
        pg8::EpiProj E{U0, N0, N0 / 256, ROWS_ACT / 256, F.out + O_MK, MKVB};
        pg8::gemm_phase<pg8::EpiProj, pg8::OrderExt, true, true>(F.lds, g, S, E);
        skinny_phase(F, A0 + (size_t)ROW_S * DM, WT0, N0, 64, SkStoreProj{U0, N0});
    }
    SEAM(1);
    if (IN(2)) {
        LAS float* tab = (LAS float*)(F.lds + SWA_TAB);
        __syncthreads(); build_bias_tab(F, tab); __syncthreads(); build_bias_tabr(F, tab, (LAS float*)(F.lds + SWA_TABR)); __syncthreads();
        if (!(fl & 4)) for (int id = F.bid; id < 256; id += F.G) { const int b = id >> 5, rem = id & 31; swa_prompt_unit(F, b, rem >> 3, rem & 7); }
        if (!(fl & 16)) for (int b = F.bid; b < NDEC; b += F.G) swa_sample_unit(F, b, tab);
        if (!(fl & 8)) for (int id = F.bid; id < 256; id += F.G) { const int b = id >> 5, rem = id & 31; mem_prompt_unit(F, 0, b, rem >> 3, rem & 7, U0, N0, 2048, 2560, fl); }
        if (!(fl & 32)) {
            if (F.G == 256) { if (F.bid < 128) mem_sample_unit(F, 0, F.bid >> 2, F.bid & 3, U0, N0, 2048, 2560);
                else for (int k3 = 0; k3 < 3; ++k3) { const int u = 128 + (F.bid - 128) * 3 + k3; mem_sample_unit(F, 0, u >> 2, u & 3, U0, N0, 2048, 2560); } }
            else for (int u = F.G - 1 - F.bid; u < NDEC * 4; u += F.G) mem_sample_unit(F, 0, u >> 2, u & 3, U0, N0, 2048, 2560); }
        for (int i = F.bid * 512 + F.tid; i < NB * 128 * 512; i += F.G * 512) { const int b = i >> 16, r = (i >> 9) & 127, c = i & 511;
            const float v = bf2f(U0[(size_t)(b * SEQ + SEQ - 128 + r) * N0 + 1536 + c]);
            if (c < 256) F.out[O_SKP + (size_t)(b * 128 + r) * 256 + c] = v; else F.out[O_SVP + (size_t)(b * 128 + r) * 256 + (c - 256)] = v; }
    }
    SEAM(2);
    if (IN(3)) {
        pg8::Gemm g{BR, WO, ROWS_ACT, DM, DM};
        pg8::OrderExt S; S.init(NTOK, DM, F.G, F.bid, 0, 0, 0, 1);
        pg8::EpiOut E{Z0, 0, A0, Z0, STATS, F.in[17], F.in[18], ALPHA};
        pg8::gemm_phase<pg8::EpiOut, pg8::OrderExt, true, true>(F.lds, g, S, E);
        skinny_phase(F, BR + (size_t)ROW_S * DM, WO, DM, 256, SkStoreOut{Z0, 0, A0, Z0, STATS, F.in[17], F.in[18]});
    }
    SEAM(3);
    if (IN(4)) { for (int m = gw; m < NTOK + NDEC; m += NGW) ln_row(Z0 + (size_t)m * DM, F.in[17], F.in[18], H1 + (size_t)m * DM, nullptr, STATS + 2 * m, F.lane); }
    SEAM(4);
    if (IN(5)) {
        pg8::Gemm g{H1, WT1, ROWS_ACT, N1, DM};
        pg8::OrderExt S; S.init(NTOK, N1, F.G, F.bid, 0, 0, 0, 1);
        pg8::EpiProj E{U1, N1, N1 / 256, 0, F.out + O_MK, MKVB};
        pg8::gemm_phase<pg8::EpiProj, pg8::OrderExt, true, true>(F.lds, g, S, E);
        skinny_phase(F, H1 + (size_t)ROW_S * DM, WT1, N1, 256, SkStoreProj{U1, N1});
    }
    SEAM(5);
    if (IN(6)) {
        if (!(fl & 1)) hgrn_prep_phase(F);
    }
    SEAM(6);
    if (IN(7)) {
        const int nH = 96;
        if (F.G > nH) {
            if (F.bid < nH) { if (!(fl & 1)) hgrn_seq_unit(F, F.bid / 12, F.bid % 12, fl); }
            else if (!(fl & 2)) { const int nO = F.G - nH;
                for (int it = F.bid - nH; it < 256 + 512; it += nO) {
                    if (it < 256) { const int b = it >> 5, rem = it & 31; mem_prompt_unit(F, 1, b, rem >> 3, rem & 7, U1, N1, 4608, 5120); }
                    else mem_sample_unit(F, 1, (it - 256) >> 2, (it - 256) & 3, U1, N1, 4608, 5120); }
                for (int u = F.G - 1 - F.bid; u < NDEC * 12; u += nO) hgrn_sample_unit(F, u / 12, u % 12); }
        } else {
            for (int u = F.bid; u < nH; u += F.G) hgrn_seq_unit(F, u / 12, u % 12, fl);
            for (int it = F.bid; it < 256 + 512; it += F.G) {
                if (it < 256) { const int b = it >> 5, rem = it & 31; mem_prompt_unit(F, 1, b, rem >> 3, rem & 7, U1, N1, 4608, 5120); }
                else mem_sample_unit(F, 1, (it - 256) >> 2, (it - 256) & 3, U1, N1, 4608, 5120); }
            for (int u = F.bid; u < NDEC * 12; u += F.G) hgrn_sample_unit(F, u / 12, u % 12);
        }
    }
    SEAM(7);
    if (IN(8)) {
        pg8::Gemm g{BR, WO + (size_t)DM * DM, ROWS_ACT, DM, DM};
        pg8::OrderExt S; S.init(NTOK, DM, F.G, F.bid, 0, 0, 0, 1);
        pg8::EpiOut E{Z1, 1, A0, Z0, STATS, F.in[17], F.in[18], ALPHA};
        pg8::gemm_phase<pg8::EpiOut, pg8::OrderExt, true, true>(F.lds, g, S, E);
        skinny_phase(F, BR + (size_t)ROW_S * DM, WO + (size_t)DM * DM, DM, 256, SkStoreOut{Z1, 1, A0, Z0, STATS, F.in[17], F.in[18]});
    }
    SEAM(8);
    if (IN(9)) { for (int m = gw; m < NTOK + NDEC; m += NGW) ln_row(Z1 + (size_t)m * DM, F.in[17] + DM, F.in[18] + DM, nullptr, F.out + (size_t)m * DM, nullptr, F.lane); }
#undef IN
#undef SEAM
}

extern "C" void kernel_launch(void* const* d_in, const int* in_sizes, int n_in, void* d_out, int out_size, void* d_ws, size_t ws_size, hipStream_t stream) {
    static int grid = 0;
    if (grid == 0) {
        if (n_in != 19 || (size_t)out_size != O_END || ws_size < WS_END) { fprintf(stderr, "kernel_launch: unexpected shapes: n_in %d out %d ws %zu (need %zu)\n", n_in, out_size, ws_size, (size_t)WS_END); grid = -1; return; }
        int dev = 0, cus = 0, per_cu = 0;
        if (hipGetDevice(&dev) != hipSuccess || hipDeviceGetAttribute(&cus, hipDeviceAttributeMultiprocessorCount, dev) != hipSuccess) { grid = -1; return; }
        if (hipFuncSetAttribute((const void*)fwd_megakernel, hipFuncAttributeMaxDynamicSharedMemorySize, LDS_BYTES) != hipSuccess) { fprintf(stderr, "kernel_launch: hipFuncSetAttribute failed\n"); grid = -1; return; }
        if (hipOccupancyMaxActiveBlocksPerMultiprocessor(&per_cu, (const void*)fwd_megakernel, 512, LDS_BYTES) != hipSuccess || per_cu < 1) { fprintf(stderr, "kernel_launch: occupancy query failed (%d)\n", per_cu); (void)hipGetLastError(); per_cu = 1; }
        grid = cus * (per_cu < 1 ? 1 : 1);
        fprintf(stderr, "kernel_launch: grid %d (cus %d, per_cu %d)\n", grid, cus, per_cu);
    }
    if (grid < 0) return;
    if (hipMemsetAsync((char*)d_ws + WS_CTL, 0, CTL_ZERO_BYTES, stream) != hipSuccess) { fprintf(stderr, "kernel_launch: memset failed\n"); return; }
    Args a{};
    for (int i = 0; i < 19; ++i) a.in[i] = (const float*)d_in[i];
    a.out = (float*)d_out; a.ws = (unsigned char*)d_ws;
#if MK_PLAN == 0
    const int plan[][3] = {{0, N_PHASES, 0}};
#elif MK_PLAN == 1
    const int plan[][3] = {{0, 3, 0}, {2, 3, 0}, {3, 8, 0}, {6, 8, 0}, {8, N_PHASES, 0}};
#elif MK_PLAN == 2
    const int plan[][3] = {{0, 1, 0}, {0, 5, 0}, {4, N_PHASES, 0}};
#elif MK_PLAN == 3
    const int plan[][3] = {{0, 3, 0}, {3, 8, 0}, {6, 8, 0}, {8, N_PHASES, 0}};
#elif MK_PLAN == 4
    const int plan[][3] = {{0, 3, 0}, {2, 3, 0}, {3, N_PHASES, 0}};
#elif MK_PLAN == 5
    const int plan[][3] = {{0, 3, 0}, {3, 8, 0}, {8, N_PHASES, 0}};
#elif MK_PLAN == 6
    const int plan[][3] = {{0, 3, 0}, {3, 7, 0}, {6, 7, 0}, {7, N_PHASES, 0}};
#elif MK_PLAN == 7
    const int plan[][3] = {{0, 3, 0}, {3, 8, 0}, {7, 8, 0}, {8, N_PHASES, 0}};
#elif MK_PLAN == 8
    const int plan[][3] = {{0, 3, 0}, {2, 3, 8 + 16 + 32}, {3, N_PHASES, 0}};
#elif MK_PLAN == 9
    const int plan[][3] = {{0, 3, 0}, {2, 3, 4 + 16 + 32}, {3, N_PHASES, 0}};
#elif MK_PLAN == 11
    const int plan[][3] = {{0, 3, 0}, {3, 8, 0}, {7, 8, 2}, {8, N_PHASES, 0}};
#elif MK_PLAN == 12
    const int plan[][3] = {{0, 3, 0}, {3, 8, 0}, {7, 8, 1}, {8, N_PHASES, 0}};
#elif MK_PLAN == 13
    const int plan[][3] = {{0, 7, 0}, {7, 8, 2 + 64}, {7, 8, 0}, {8, N_PHASES, 0}};
#elif MK_PLAN == 14
    const int plan[][3] = {{0, 7, 0}, {7, 8, 2 + 128}, {7, 8, 0}, {8, N_PHASES, 0}};
#elif MK_PLAN == 15
    const int plan[][3] = {{0, 7, 0}, {7, 8, 2}, {7, 8, 0}, {8, N_PHASES, 0}};
#elif MK_PLAN == 16
    const int plan[][3] = {{0, 7, 0}, {7, 8, 2 + 64 + 256}, {7, 8, 0}, {8, N_PHASES, 0}};
#elif MK_PLAN == 17
    const int plan[][3] = {{0, 7, 0}, {7, 8, 2 + 64 + 128 + 512}, {7, 8, 0}, {8, N_PHASES, 0}};
#elif MK_PLAN == 18
    const int plan[][3] = {{0, 2, 0}, {1, 2, 0}, {2, 6, 0}, {5, 6, 0}, {6, N_PHASES, 0}};
#elif MK_PLAN == 19
    const int plan[][3] = {{0, 4, 0}, {3, 4, 0}, {4, 9, 0}, {8, 9, 0}, {9, N_PHASES, 0}};
#elif MK_PLAN == 20
    const int plan[][3] = {{0, 2, 0}, {2, 3, 4 + 16 + 32 + 1024}, {2, 3, 0}, {3, N_PHASES, 0}};
#elif MK_PLAN == 21
    const int plan[][3] = {{0, 2, 0}, {2, 3, 4 + 16 + 32 + 2048}, {2, 3, 0}, {3, N_PHASES, 0}};
#elif MK_PLAN == 22
    const int plan[][3] = {{0, 2, 0}, {2, 3, 4 + 16 + 32 + 4096}, {2, 3, 0}, {3, N_PHASES, 0}};
#elif MK_PLAN == 23
    const int plan[][3] = {{0, 2, 0}, {2, 3, 4 + 16 + 32 + 16384}, {2, 3, 0}, {3, N_PHASES, 0}};
#elif MK_PLAN == 24
    const int plan[][3] = {{0, 2, 0}, {2, 3, 4 + 16 + 32 + 4096 + 16384}, {2, 3, 0}, {3, N_PHASES, 0}};
#elif MK_PLAN == 25
    const int plan[][3] = {{0, 2, 0}, {2, 3, 4 + 16 + 32}, {2, 3, 0}, {3, N_PHASES, 0}};
#elif MK_PLAN == 10
    const int plan[][3] = {{0, 3, 0}, {2, 3, 4 + 8}, {3, N_PHASES, 0}};
#endif
    const int nl = (int)(sizeof(plan) / sizeof(plan[0]));
    for (int li = 0; li < nl; ++li) {
        a.ph_lo = plan[li][0]; a.ph_hi = plan[li][1]; a.li = li; a.flags = plan[li][2];
        void* kargs[] = {&a};
        hipError_t e = hipLaunchCooperativeKernel((const void*)fwd_megakernel, dim3(grid), dim3(512), kargs, LDS_BYTES, stream);
        if (e != hipSuccess) { fprintf(stderr, "kernel_launch: cooperative launch %d failed: %s (grid %d)\n", li, hipGetErrorString(e), grid); break; }
    }
}
```

```cpp
#include <hip/hip_runtime.h>
#include <hip/hip_cooperative_groups.h>
#include <cstdio>
#include <cstdint>
namespace cg = cooperative_groups;
namespace pg8 {
#define PG8_LAS __attribute__((address_space(3)))
typedef unsigned short bf16_t;
typedef short bf16x8 __attribute__((ext_vector_type(8)));
typedef float f32x4 __attribute__((ext_vector_type(4)));
typedef unsigned u32x4 __attribute__((ext_vector_type(4)));
constexpr int BM = 256, BK = 64, HALF = 128, HTB = HALF * BK * 2  , STAGE_BYTES = 8 * HTB, NXCD = 8, WGM = 8;

__host__ __device__ __forceinline__ int lds_byte(int r, int c) { const int st = (r >> 4) * 2 + (c >> 5), rr = r & 15, cc = c & 31, ob = rr * 64 + cc * 2; return st * 1024 + (ob ^ (((ob >> 9) & 1) << 5)); }
__host__ __device__ __forceinline__ void stage_rc(int b, int& R, int& C) { const int st = b / 1024, sb = b % 1024, swz = sb ^ (((sb >> 9) & 1) << 5); R = (st >> 1) * 16 + swz / 64; C = (st & 1) * 32 + (swz % 64) / 2; }
__host__ __device__ __forceinline__ int perm32(int rho) { const int n = rho >> 4, i = rho & 15; return 8 * (i >> 2) + 4 * n + (i & 3); }

struct Unit { int pm, pn; };
struct Gemm { const bf16_t* A; const bf16_t* Bt; int M, N, K; };

struct StaticOrder {
    int nM, nN, nwg, G, c;
    __host__ __device__ void init(int M, int N, int G_, int c_) { nM = M / BM; nN = N / BM; nwg = nM * nN; G = G_; c = c_; }
    __host__ __device__ bool next(int i, Unit& u) const {
        const long L = (long)i * G + c; if (L >= nwg) return false;
        int wgid = (int)L; { const int q = nwg / NXCD, r = nwg % NXCD, xcd = wgid % NXCD, off = wgid / NXCD; wgid = (xcd < r ? xcd * (q + 1) : r * (q + 1) + (xcd - r) * q) + off; }
        const int nig = WGM * nN, gid = wgid / nig, fm = gid * WGM, gsz = (nM - fm) < WGM ? (nM - fm) : WGM;
        u.pm = fm + ((wgid % nig) % gsz); u.pn = (wgid % nig) / gsz; return true;
    }
    __device__ __forceinline__ void a_ready(const Unit&) const {}
    __device__ __forceinline__ void done(const Unit&) const {}
};

__device__ __forceinline__ unsigned cvt_pk_bf16(float lo, float hi) { unsigned r; asm volatile("v_cvt_pk_bf16_f32 %0, %1, %2" : "=v"(r) : "v"(lo), "v"(hi)); return r; }
typedef float f32x2 __attribute__((ext_vector_type(2)));
__device__ __forceinline__ f32x2 gelu_pk(f32x2 v) {
    const f32x2 av = __builtin_elementwise_abs(v), d = av * 0.2316418882f + 1.0f;
    f32x2 t; t.x = __builtin_amdgcn_rcpf(d.x); t.y = __builtin_amdgcn_rcpf(d.y);
    f32x2 q = t * 0.5307027145f + (-0.7265760135f); q = q * t + 0.7107068705f; q = q * t + (-0.142248368f); q = q * t + 0.127414796f; q = q * t;
    const f32x2 s = (v * v) * (-0.72134752044f);
    f32x2 e; e.x = __builtin_amdgcn_exp2f(s.x); e.y = __builtin_amdgcn_exp2f(s.y);
    const f32x2 m = v * (q * e), r = v - m;
    f32x2 o; o.x = v.x < 0.f ? m.x : r.x; o.y = v.y < 0.f ? m.y : r.y; return o;
}


struct EpiProj {
    static constexpr bool PERM = true, AFTER_DRAIN = false;
    bf16_t* U; int ldu; int n_main_pn; int mem_pm0; float* memf; bf16_t* memb;
    __device__ __forceinline__ void operator()(const f32x4 (&acc)[2][2][4][2], const Unit& u, int wr, int wc, int fr, int fq) const {
        if (u.pn < n_main_pn) {
            const int row0 = u.pm * BM + wr * 64 + fr, col0 = u.pn * BM + wc * 32 + 8 * fq;
#pragma unroll
            for (int ai = 0; ai < 2; ++ai)
#pragma unroll
                for (int m = 0; m < 4; ++m) { bf16_t* rowp = U + (size_t)(row0 + ai * HALF + m * 16) * ldu + col0;
#pragma unroll
                    for (int bj = 0; bj < 2; ++bj) { const f32x4 v0 = acc[ai][bj][m][0], v1 = acc[ai][bj][m][1]; u32x4 w;
                        w.x = cvt_pk_bf16(v0[0], v0[1]); w.y = cvt_pk_bf16(v0[2], v0[3]); w.z = cvt_pk_bf16(v1[0], v1[1]); w.w = cvt_pk_bf16(v1[2], v1[3]);
                        __builtin_nontemporal_store(w, (u32x4*)(rowp + bj * HALF)); } }
        } else {
            const int t = (u.pn - n_main_pn) >> 1, colt = ((u.pn - n_main_pn) & 1) * 256;
            const int row0 = (u.pm - mem_pm0) * BM + wr * 64 + fr, col0 = colt + wc * 32 + 8 * fq;
            float* fb = memf + (size_t)t * (2048 * 512); bf16_t* bb = memb + (size_t)t * (2048 * 512);
#pragma unroll
            for (int ai = 0; ai < 2; ++ai)
#pragma unroll
                for (int m = 0; m < 4; ++m) { const size_t ro = (size_t)(row0 + ai * HALF + m * 16) * 512 + col0;
#pragma unroll
                    for (int bj = 0; bj < 2; ++bj) { const f32x4 v0 = acc[ai][bj][m][0], v1 = acc[ai][bj][m][1]; u32x4 w;
                        __builtin_nontemporal_store(v0, (f32x4*)(fb + ro + bj * HALF)); __builtin_nontemporal_store(v1, (f32x4*)(fb + ro + bj * HALF + 4));
                        w.x = cvt_pk_bf16(v0[0], v0[1]); w.y = cvt_pk_bf16(v0[2], v0[3]); w.z = cvt_pk_bf16(v1[0], v1[1]); w.w = cvt_pk_bf16(v1[2], v1[3]);
                        *(u32x4*)(bb + ro + bj * HALF) = w; } }
        }
    }
};
struct EpiOut {
    static constexpr bool PERM = true, AFTER_DRAIN = false;
    bf16_t* Z; int mode; const bf16_t* xb; const bf16_t* zprev; const float* stats; const float* lnw; const float* lnb; float alpha;
    __device__ __forceinline__ static void unpack8(const u32x4 w, f32x4& lo, f32x4& hi) {
        lo = (f32x4){__uint_as_float(w.x << 16), __uint_as_float(w.x & 0xffff0000u), __uint_as_float(w.y << 16), __uint_as_float(w.y & 0xffff0000u)};
        hi = (f32x4){__uint_as_float(w.z << 16), __uint_as_float(w.z & 0xffff0000u), __uint_as_float(w.w << 16), __uint_as_float(w.w & 0xffff0000u)}; }
    __device__ __forceinline__ void operator()(const f32x4 (&acc)[2][2][4][2], const Unit& u, int wr, int wc, int fr, int fq) const {
        const int row0 = u.pm * BM + wr * 64 + fr, col0 = u.pn * BM + wc * 32 + 8 * fq;
        f32x4 lw[2][2], lb[2][2];
        if (mode == 1) {
#pragma unroll
            for (int bj = 0; bj < 2; ++bj) { lw[bj][0] = *(const f32x4*)(lnw + col0 + bj * HALF); lw[bj][1] = *(const f32x4*)(lnw + col0 + bj * HALF + 4);
                lb[bj][0] = *(const f32x4*)(lnb + col0 + bj * HALF); lb[bj][1] = *(const f32x4*)(lnb + col0 + bj * HALF + 4); }
        }
        const bf16_t* src = mode == 1 ? zprev : xb;
#pragma unroll
        for (int ai = 0; ai < 2; ++ai)
#pragma unroll
            for (int m = 0; m < 4; ++m) { const int row = row0 + ai * HALF + m * 16; const size_t ro = (size_t)row * 2048 + col0;
                float mu = 0.f, rs = 1.f; if (mode == 1) { mu = stats[2 * row]; rs = stats[2 * row + 1]; }
#pragma unroll
                for (int bj = 0; bj < 2; ++bj) { f32x4 r0, r1; unpack8(*(const u32x4*)(src + ro + bj * HALF), r0, r1);
                    if (mode == 1) { r0 = (r0 - mu) * rs * lw[bj][0] + lb[bj][0]; r1 = (r1 - mu) * rs * lw[bj][1] + lb[bj][1]; }
                    const f32x4 v0 = r0 * alpha + acc[ai][bj][m][0], v1 = r1 * alpha + acc[ai][bj][m][1]; u32x4 w;
                    w.x = cvt_pk_bf16(v0[0], v0[1]); w.y = cvt_pk_bf16(v0[2], v0[3]); w.z = cvt_pk_bf16(v1[0], v1[1]); w.w = cvt_pk_bf16(v1[2], v1[3]);
                    *(u32x4*)(Z + ro + bj * HALF) = w; } }
    }
};
struct OrderExt {
    StaticOrder so; int n_main, n_ext, ext_pm0, ext_pn0, ext_nm;
    __host__ __device__ void init(int M, int N, int G_, int c_, int n_ext_, int ext_pm0_, int ext_pn0_, int ext_nm_) { so.init(M, N, G_, c_); n_main = so.nwg; n_ext = n_ext_; ext_pm0 = ext_pm0_; ext_pn0 = ext_pn0_; ext_nm = ext_nm_; }
    __host__ __device__ bool next(int i, Unit& u) const {
        const long L = (long)i * so.G + so.c;
        if (L < n_main) return so.next(i, u);
        const int e = (int)(L - n_main); if (e >= n_ext) return false;
        u.pm = ext_pm0 + e % ext_nm; u.pn = ext_pn0 + e / ext_nm; return true;
    }
    __device__ __forceinline__ void a_ready(const Unit&) const {}
    __device__ __forceinline__ void done(const Unit&) const {}
};
template <class Epi, class Sched, bool ALIGN_EPI = false, bool SP2 = false>
__device__ __forceinline__ void gemm_phase(PG8_LAS unsigned char* lds, const Gemm g, const Sched& S, const Epi& E) {
    const int tid = threadIdx.x, wid = __builtin_amdgcn_readfirstlane(tid >> 6), lane = tid & 63, wr = wid >> 2, wc = wid & 3, fr = lane & 15, fq = lane >> 4;
    const int K = g.K, nt = K / BK;
    unsigned voffA[2], voffB[2];
#pragma unroll
    for (int i = 0; i < 2; ++i) { int R, C; stage_rc(tid * 16 + i * 8192, R, C); const int Rb = Epi::PERM ? ((R & ~31) + perm32(R & 31)) : R;
        voffA[i] = (unsigned)(R * K + C) * 2u; voffB[i] = (unsigned)(Rb * K + C) * 2u; }
    const size_t kstep = (size_t)(BK * 2);
    const size_t hstep = (size_t)HALF * K * 2;
    const size_t tstep = 2 * hstep;
    const unsigned ldsw = (unsigned)wid * 1024u;
    const int aoff = lds_byte(wr * 64 + fr, fq * 8), boff = lds_byte(wc * 32 + fr, fq * 8);
#define PG8_SA(b, h) (((b) * 2 + (h)) * HTB)
#define PG8_SB(b, h) ((4 + (b) * 2 + (h)) * HTB)
#define PG8_STAGE(bufoff, gbase, voff) do { _Pragma("unroll") for (int _i = 0; _i < 2; ++_i) \
        __builtin_amdgcn_global_load_lds((const unsigned*)((const char*)(gbase) + (voff)[_i]), (PG8_LAS unsigned*)(lds + (bufoff) + ldsw + _i * 8192), 16, 0, 0); } while (0)
#define PG8_LDA(dst, b, h) do { _Pragma("unroll") for (int m = 0; m < 4; ++m) _Pragma("unroll") for (int k = 0; k < 2; ++k) dst[m][k] = *(const PG8_LAS bf16x8*)(lds + PG8_SA(b, h) + aoff + m * 2048 + k * 1024); } while (0)
#define PG8_LDB(dst, b, h) do { _Pragma("unroll") for (int n = 0; n < 2; ++n) _Pragma("unroll") for (int k = 0; k < 2; ++k) dst[n][k] = *(const PG8_LAS bf16x8*)(lds + PG8_SB(b, h) + boff + n * 2048 + k * 1024); } while (0)
#define PG8_MMA(ai, bj, At, Bt) do { __builtin_amdgcn_s_setprio(1); _Pragma("unroll") for (int m = 0; m < 4; ++m) _Pragma("unroll") for (int n = 0; n < 2; ++n) _Pragma("unroll") for (int k = 0; k < 2; ++k) \
        acc[ai][bj][m][n] = __builtin_amdgcn_mfma_f32_16x16x32_bf16(Bt[n][k], At[m][k], acc[ai][bj][m][n], 0, 0, 0); __builtin_amdgcn_s_setprio(0); } while (0)
#define PG8_WAIT_V(n) asm volatile("s_waitcnt vmcnt(" #n ")" ::: "memory")
#define PG8_WAIT_L(n) asm volatile("s_waitcnt lgkmcnt(" #n ")" ::: "memory")
#define PG8_BAR __builtin_amdgcn_s_barrier()
#define PG8_SCHED __builtin_amdgcn_sched_barrier(0)
    Unit cur, nxt; int ui = 0;
    if (!S.next(0, cur)) return;
    f32x4 acc[2][2][4][2];
#pragma unroll
    for (int a = 0; a < 2; ++a)
#pragma unroll
        for (int b = 0; b < 2; ++b)
#pragma unroll
            for (int m = 0; m < 4; ++m)
#pragma unroll
                for (int n = 0; n < 2; ++n) acc[a][b][m][n] = (f32x4){0.f, 0.f, 0.f, 0.f};
    bf16x8 At[4][2], B0[2][2], B1[2][2];
    const char* cA = (const char*)g.A + (size_t)cur.pm * tstep; const char* cB = (const char*)g.Bt + (size_t)cur.pn * tstep;
    S.a_ready(cur);
    if constexpr (SP2) {
        PG8_STAGE(PG8_SB(0, 0), cB, voffB); PG8_STAGE(PG8_SB(0, 1), cB + hstep, voffB); PG8_STAGE(PG8_SA(0, 0), cA, voffA); PG8_STAGE(PG8_SA(0, 1), cA + hstep, voffA);
        if (wr == 1) PG8_BAR;
        PG8_WAIT_V(2); PG8_BAR;
        PG8_STAGE(PG8_SB(1, 0), cB + kstep, voffB); PG8_STAGE(PG8_SA(1, 0), cA + kstep, voffA); PG8_STAGE(PG8_SB(1, 1), cB + hstep + kstep, voffB);
        PG8_WAIT_V(6); PG8_BAR;
    } else {
        PG8_STAGE(PG8_SB(0, 0), cB, voffB); PG8_STAGE(PG8_SA(0, 0), cA, voffA); PG8_STAGE(PG8_SB(0, 1), cB + hstep, voffB); PG8_STAGE(PG8_SA(0, 1), cA + hstep, voffA);
        if (wr == 1) PG8_BAR;
        PG8_WAIT_V(4); PG8_BAR;
        PG8_STAGE(PG8_SB(1, 0), cB + kstep, voffB); PG8_STAGE(PG8_SA(1, 0), cA + kstep, voffA); PG8_STAGE(PG8_SB(1, 1), cB + hstep + kstep, voffB);
        PG8_WAIT_V(6); PG8_BAR;
    }
    for (;;) {
        const bool has_next = S.next(ui + 1, nxt);
        const char* nA = has_next ? (const char*)g.A + (size_t)nxt.pm * tstep : cA; const char* nB = has_next ? (const char*)g.Bt + (size_t)nxt.pn * tstep : cB;
        for (int t = 0; t < nt; t += 2) {
            const bool last = (t == nt - 2);
            const char* a1 = cA + (size_t)(t + 1) * kstep;
            const char* a2 = last ? nA : cA + (size_t)(t + 2) * kstep; const char* b2 = last ? nB : cB + (size_t)(t + 2) * kstep;
            const char* a3 = a2 + kstep; const char* b3 = b2 + kstep;
            if (last && has_next) S.a_ready(nxt);
            if constexpr (SP2) {
            PG8_LDB(B0, 0, 0); PG8_LDB(B1, 0, 1); PG8_SCHED; PG8_LDA(At, 0, 0); PG8_STAGE(PG8_SA(1, 1), a1 + hstep, voffA);
            PG8_WAIT_V(8); PG8_WAIT_L(0); PG8_BAR; PG8_MMA(0, 0, At, B0); PG8_MMA(0, 1, At, B1); PG8_BAR; PG8_SCHED;
            PG8_LDA(At, 0, 1); PG8_STAGE(PG8_SB(0, 0), b2, voffB); PG8_STAGE(PG8_SB(0, 1), b2 + hstep, voffB); PG8_STAGE(PG8_SA(0, 0), a2, voffA);
            PG8_WAIT_V(8); PG8_WAIT_L(0); PG8_BAR; PG8_MMA(1, 0, At, B0); PG8_MMA(1, 1, At, B1); PG8_BAR; PG8_SCHED;
            PG8_LDB(B0, 1, 0); PG8_LDB(B1, 1, 1); PG8_SCHED; PG8_LDA(At, 1, 0); PG8_STAGE(PG8_SA(0, 1), a2 + hstep, voffA);
            PG8_WAIT_V(8); PG8_WAIT_L(0); PG8_BAR; PG8_MMA(0, 0, At, B0); PG8_MMA(0, 1, At, B1); PG8_BAR; PG8_SCHED;
            PG8_LDA(At, 1, 1); PG8_STAGE(PG8_SB(1, 0), b3, voffB); PG8_STAGE(PG8_SB(1, 1), b3 + hstep, voffB); PG8_STAGE(PG8_SA(1, 0), a3, voffA);
            PG8_WAIT_V(8); PG8_WAIT_L(0); PG8_BAR; PG8_MMA(1, 0, At, B0); PG8_MMA(1, 1, At, B1); PG8_BAR; PG8_SCHED;
            } else {
            PG8_LDB(B0, 0, 0); PG8_SCHED; PG8_LDA(At, 0, 0); PG8_STAGE(PG8_SA(1, 1), a1 + hstep, voffA);
            PG8_WAIT_L(8); PG8_BAR; PG8_WAIT_L(0); PG8_MMA(0, 0, At, B0); PG8_BAR; PG8_SCHED;
            PG8_LDB(B1, 0, 1); PG8_STAGE(PG8_SB(0, 0), b2, voffB);
            PG8_BAR; PG8_WAIT_L(0); PG8_MMA(0, 1, At, B1); PG8_BAR;
            PG8_LDA(At, 0, 1); PG8_STAGE(PG8_SA(0, 0), a2, voffA);
            PG8_BAR; PG8_WAIT_L(0); PG8_MMA(1, 0, At, B0); PG8_BAR; PG8_SCHED;
            PG8_STAGE(PG8_SB(0, 1), b2 + hstep, voffB);
            PG8_WAIT_V(6); PG8_BAR; PG8_MMA(1, 1, At, B1); PG8_BAR;
            PG8_LDB(B0, 1, 0); PG8_SCHED; PG8_LDA(At, 1, 0); PG8_STAGE(PG8_SA(0, 1), a2 + hstep, voffA);
            PG8_WAIT_L(8); PG8_BAR; PG8_WAIT_L(0); PG8_MMA(0, 0, At, B0); PG8_BAR; PG8_SCHED;
            PG8_LDB(B1, 1, 1); PG8_STAGE(PG8_SB(1, 0), b3, voffB);
            PG8_BAR; PG8_WAIT_L(0); PG8_MMA(0, 1, At, B1); PG8_BAR;
            PG8_LDA(At, 1, 1); PG8_STAGE(PG8_SA(1, 0), a3, voffA);
            PG8_BAR; PG8_WAIT_L(0); PG8_MMA(1, 0, At, B0); PG8_BAR; PG8_SCHED;
            PG8_STAGE(PG8_SB(1, 1), b3 + hstep, voffB);
            PG8_WAIT_V(6); PG8_BAR; PG8_MMA(1, 1, At, B1); PG8_BAR;
            }
        }
        if constexpr (ALIGN_EPI) { if (wr == 0) PG8_BAR; }
        if constexpr (!Epi::AFTER_DRAIN) { E(acc, cur, wr, wc, fr, fq); S.done(cur); }
        if (!has_next) break;
#pragma unroll
        for (int a = 0; a < 2; ++a)
#pragma unroll
            for (int b = 0; b < 2; ++b)
#pragma unroll
                for (int m = 0; m < 4; ++m)
#pragma unroll
                    for (int n = 0; n < 2; ++n) acc[a][b][m][n] = (f32x4){0.f, 0.f, 0.f, 0.f};
        cur = nxt; cA = nA; cB = nB; ++ui;
        if constexpr (ALIGN_EPI) { if (wr == 1) PG8_BAR; }
    }
    PG8_WAIT_V(0);
    if constexpr (!ALIGN_EPI) { if (wr == 0) PG8_BAR; }
    PG8_BAR;
    if constexpr (Epi::AFTER_DRAIN) { E.fused(acc, cur, wr, wc, fr, fq, lds, wid, lane); S.done(cur); }
#undef PG8_SA
#undef PG8_SB
#undef PG8_STAGE
#undef PG8_LDA
#undef PG8_LDB
#undef PG8_MMA
#undef PG8_WAIT_V
#undef PG8_WAIT_L
#undef PG8_BAR
#undef PG8_SCHED
}
}

constexpr int DM = 2048, NB = 8, SEQ = 2048, NTOK = NB * SEQ, NDEC = 128;
constexpr int ROW_S = NTOK;
constexpr int ROWS_ACT = NTOK + 256;
constexpr int ROW_MEM = ROWS_ACT;
constexpr int A0_ROWS = ROWS_ACT + 2048;
constexpr int N0 = 4608, N1 = 7168;
constexpr float ALPHA = 1.41421356237f;
constexpr size_t O_YP = 0, O_YS = 33554432, O_MK = 33816576, O_MV = 35913728, O_SKP = 38010880, O_SVP = 38273024, O_HSP = 38535168, O_SKS = 40108032, O_SVS = 44302336, O_HSS = 48496640, O_END = 73662464;
constexpr size_t MiB = 1u << 20;
constexpr size_t WS_CTL = 0, WS_WT0 = 1 * MiB, WS_WT1 = 27 * MiB, WS_WO = 55 * MiB, WS_MKVB = 71 * MiB, WS_MISC = 79 * MiB, WS_R1 = 80 * MiB;
constexpr size_t WS_A0 = WS_R1, WS_U0 = WS_R1 + 73 * MiB, WS_U1 = WS_R1, WS_BR = 308 * MiB, WS_Z0 = 373 * MiB, WS_Z1 = 438 * MiB  , WS_H1 = 503 * MiB, WS_HG = 503 * MiB  , WS_END = 625 * MiB;
static_assert((size_t)A0_ROWS * DM * 2 <= 73 * MiB && WS_U0 + (size_t)ROWS_ACT * N0 * 2 <= WS_BR && WS_U1 + (size_t)ROWS_ACT * N1 * 2 <= WS_BR, "ws map");
static_assert(WS_BR + (size_t)ROWS_ACT * DM * 2 <= WS_Z0 && WS_Z0 + (size_t)ROWS_ACT * DM * 2 <= WS_Z1 && WS_Z1 + (size_t)ROWS_ACT * DM * 2 <= WS_H1 && WS_H1 + (size_t)ROWS_ACT * DM * 2 <= WS_END && WS_HG + (size_t)3072 * 41472 <= WS_END, "ws map");
constexpr int LDS_BYTES = 147456;

#define LAS __attribute__((address_space(3)))
typedef unsigned short bf16;
typedef unsigned v4u __attribute__((ext_vector_type(4)));
typedef unsigned v2u __attribute__((ext_vector_type(2)));
typedef float f32x4 __attribute__((ext_vector_type(4)));
typedef float f32x2 __attribute__((ext_vector_type(2)));
typedef short bf16x8 __attribute__((ext_vector_type(8)));
typedef short s16x4 __attribute__((ext_vector_type(4)));
typedef __bf16 bf16x2_t __attribute__((ext_vector_type(2)));
#define LDS_WAIT() asm volatile("s_waitcnt lgkmcnt(0)" ::: "memory")
#define LDS_BARRIER() do { asm volatile("s_waitcnt lgkmcnt(0)" ::: "memory"); __builtin_amdgcn_s_barrier(); asm volatile("" ::: "memory"); } while (0)

__device__ __forceinline__ float bf2f(unsigned short b) { return __uint_as_float((unsigned)b << 16); }
__device__ __forceinline__ unsigned pk2(float lo, float hi) { f32x2 v = {lo, hi}; bf16x2_t b = __builtin_convertvector(v, bf16x2_t); return __builtin_bit_cast(unsigned, b); }
__device__ __forceinline__ unsigned short f2bf(float f) { return (unsigned short)(pk2(f, 0.f) & 0xffffu); }
__device__ __forceinline__ float fast_rcp(float x) { return __builtin_amdgcn_rcpf(x); }
__device__ __forceinline__ float silu_f(float x) { return x * fast_rcp(1.f + __expf(-x)); }
__device__ __forceinline__ float sigmoid_f(float x) { return fast_rcp(1.f + __expf(-x)); }
__device__ __forceinline__ s16x4 vtr(const LAS unsigned char* p) { typedef short v4i16_t __attribute__((ext_vector_type(4))); return __builtin_bit_cast(s16x4, __builtin_amdgcn_ds_read_tr16_b64_v4i16((LAS v4i16_t*)p)); }
__device__ __forceinline__ float wave_sum(float v) {
#pragma unroll
    for (int o = 1; o < 64; o <<= 1) v += __shfl_xor(v, o);
    return v;
}
__device__ __forceinline__ float wave_max(float v) {
#pragma unroll
    for (int o = 1; o < 64; o <<= 1) v = fmaxf(v, __shfl_xor(v, o));
    return v;
}

__device__ __forceinline__ const unsigned char* uni_ptr(const void* p) { const unsigned long long v = (unsigned long long)p;
    const unsigned lo = __builtin_amdgcn_readfirstlane((unsigned)v), hi = __builtin_amdgcn_readfirstlane((unsigned)(v >> 32)); return (const unsigned char*)(((unsigned long long)hi << 32) | lo); }

struct Frame {
    LAS unsigned char* lds;
    int tid, lane, wave, G, bid;
    const float* in[19]; float* out; unsigned char* ws;
};

__device__ __forceinline__ void p0_transpose_item(const float* W, int K, int N, bf16* WT, int row_off, LAS float* scr, int item, int lane) {
    const int nblk = N / 32, kb = item / nblk, nb = item % nblk, k0 = 64 * kb, n0 = 32 * nb;
    const int kr = lane >> 3, c4 = lane & 7; f32x4 v[8];
#pragma unroll
    for (int i = 0; i < 8; ++i) v[i] = __builtin_nontemporal_load((const f32x4*)(W + (size_t)(k0 + 8 * i + kr) * N + n0 + 4 * c4));
#pragma unroll
    for (int i = 0; i < 8; ++i) { LAS float* d = scr + (8 * i + kr) * 33 + 4 * c4; d[0] = v[i].x; d[1] = v[i].y; d[2] = v[i].z; d[3] = v[i].w; }
    LDS_WAIT(); asm volatile("" ::: "memory");
    const int c = lane & 7;
#pragma unroll
    for (int j = 0; j < 4; ++j) { const int n = (lane >> 3) + 8 * j; const LAS float* s = scr + (8 * c) * 33 + n;
        v4u o; o.x = pk2(s[0 * 33], s[1 * 33]); o.y = pk2(s[2 * 33], s[3 * 33]); o.z = pk2(s[4 * 33], s[5 * 33]); o.w = pk2(s[6 * 33], s[7 * 33]);
        *(v4u*)(WT + (size_t)(row_off + n0 + n) * K + k0 + 8 * c) = o; }
    LDS_WAIT(); asm volatile("" ::: "memory");
}
__device__ __forceinline__ void cvt_row(const float* src, bf16* dst, int lane) {
    const f32x4* s = (const f32x4*)src + lane; v2u* d = (v2u*)dst + lane;
#pragma unroll
    for (int j = 0; j < 8; ++j) { const f32x4 v = __builtin_nontemporal_load(s + 64 * j); v2u o; o.x = pk2(v.x, v.y); o.y = pk2(v.z, v.w); d[64 * j] = o; }
}
__device__ __forceinline__ void p0_prologue(Frame& F) {
    LAS float* scr = (LAS float*)(F.lds + F.wave * 16384);
    const int gw = F.bid * 8 + F.wave, NGW = F.G * 8;
    bf16* WT0 = (bf16*)(F.ws + WS_WT0); bf16* WT1 = (bf16*)(F.ws + WS_WT1); bf16* WO = (bf16*)(F.ws + WS_WO); bf16* A0 = (bf16*)(F.ws + WS_A0);
    constexpr int I_IN0 = 32 * (N0 / 32), I_MEM = 32 * 16, I_IN1 = 32 * (N1 / 32), I_OUT = 32 * 64;
    constexpr int NITEMS = I_IN0 + 4 * I_MEM + I_IN1 + 2 * I_OUT;
    for (int it = gw; it < NITEMS; it += NGW) {
        int r = it;
        if (r < I_IN0) { p0_transpose_item(F.in[9], DM, N0, WT0, 0, scr, r, F.lane); continue; } r -= I_IN0;
        if (r < 4 * I_MEM) { const int t = r / I_MEM; const float* w = (t < 2 ? F.in[14] : F.in[15]) + (size_t)(t & 1) * DM * 512;
            p0_transpose_item(w, DM, 512, WT0, N0 + 512 * t, scr, r % I_MEM, F.lane); continue; } r -= 4 * I_MEM;
        if (r < I_IN1) { p0_transpose_item(F.in[11], DM, N1, WT1, 0, scr, r, F.lane); continue; } r -= I_IN1;
        { const int l = r / I_OUT; p0_transpose_item(F.in[16] + (size_t)l * DM * DM, DM, DM, WO + (size_t)l * DM * DM, 0, scr, r % I_OUT, F.lane); }
    }
    for (int m = gw; m < A0_ROWS; m += NGW) {
        bf16* dst = A0 + (size_t)m * DM;
        if (m < NTOK) cvt_row(F.in[0] + (size_t)m * DM, dst, F.lane);
        else if (m < NTOK + NDEC) cvt_row(F.in[1] + (size_t)(m - NTOK) * DM, dst, F.lane);
        else if (m < ROW_MEM) { v4u z = {0u, 0u, 0u, 0u}; v4u* d = (v4u*)dst + F.lane;
#pragma unroll
            for (int j = 0; j < 4; ++j) d[64 * j] = z; }
        else cvt_row(F.in[7] + (size_t)(m - ROW_MEM) * DM, dst, F.lane);
    }
}

__device__ __forceinline__ void ln_row(const bf16* z, const float* w, const float* bb, bf16* obf, float* of32, float* st, int lane) {
    const v4u* zr = (const v4u*)z + lane; float v[32]; float s = 0.f;
#pragma unroll
    for (int j = 0; j < 4; ++j) { const v4u q = __builtin_nontemporal_load(zr + 64 * j);
        v[8 * j + 0] = __uint_as_float(q.x << 16); v[8 * j + 1] = __uint_as_float(q.x & 0xffff0000u); v[8 * j + 2] = __uint_as_float(q.y << 16); v[8 * j + 3] = __uint_as_float(q.y & 0xffff0000u);
        v[8 * j + 4] = __uint_as_float(q.z << 16); v[8 * j + 5] = __uint_as_float(q.z & 0xffff0000u); v[8 * j + 6] = __uint_as_float(q.w << 16); v[8 * j + 7] = __uint_as_float(q.w & 0xffff0000u);
#pragma unroll
        for (int i = 0; i < 8; ++i) s += v[8 * j + i]; }
    const float mean = wave_sum(s) * (1.f / DM); float s2 = 0.f;
#pragma unroll
    for (int i = 0; i < 32; ++i) { v[i] -= mean; s2 += v[i] * v[i]; }
    const float rstd = 1.f / sqrtf(wave_sum(s2) * (1.f / DM) + 1e-5f);
    if (st && lane == 0) { st[0] = mean; st[1] = rstd; }
#pragma unroll
    for (int j = 0; j < 4; ++j) { const int e0 = (lane + 64 * j) * 8; const f32x4 w0 = *(const f32x4*)(w + e0), w1 = *(const f32x4*)(w + e0 + 4), b0 = *(const f32x4*)(bb + e0), b1 = *(const f32x4*)(bb + e0 + 4);
        const f32x4 y0 = (f32x4){v[8 * j], v[8 * j + 1], v[8 * j + 2], v[8 * j + 3]} * rstd * w0 + b0, y1 = (f32x4){v[8 * j + 4], v[8 * j + 5], v[8 * j + 6], v[8 * j + 7]} * rstd * w1 + b1;
        if (of32) { __builtin_nontemporal_store(y0, (f32x4*)(of32 + e0)); __builtin_nontemporal_store(y1, (f32x4*)(of32 + e0 + 4)); }
        if (obf) { v4u o; o.x = pk2(y0.x, y0.y); o.y = pk2(y0.z, y0.w); o.z = pk2(y1.x, y1.y); o.w = pk2(y1.z, y1.w); *(v4u*)(obf + e0) = o; } }
}

__device__ __forceinline__ void build_bias_tab(Frame& F, LAS float* tab) {
    const float* rb = F.in[8];
    for (int i = F.tid; i < 24 * 128; i += 512) { const int h = i >> 7, d = i & 127; int bk;
        if (d < 16) bk = d; else { bk = 16 + (int)(logf((float)d / 16.f) / 2.0794415416798357f * 16.f); bk = bk < 31 ? bk : 31; }
        tab[i] = rb[bk * 24 + h]; }
}
constexpr int SWA_TABR = 131072, TABR_LD = 160;
__device__ __forceinline__ void build_bias_tabr(Frame& F, const LAS float* tab, LAS float* tabr) {
    for (int i = F.tid; i < 24 * TABR_LD; i += 512) { const int h = i / TABR_LD, x = i % TABR_LD, d = 16 + 127 - x; tabr[i] = (d >= 0 && d < 128) ? tab[h * 128 + d] * 1.4426950408889634f : 0.f; }
}
constexpr int SWA_ROWS = 400, SWA_KS = 0, SWA_VS = SWA_ROWS * 144, SWA_TAB = 2 * SWA_ROWS * 144;
static_assert(SWA_TAB + 24 * 128 * 4 <= SWA_TABR, "SWA LDS map");
__device__ __forceinline__ void swa_prompt_unit(Frame& F, int b, int kvh, int qb4) {
    const bf16* U0 = (const bf16*)(F.ws + WS_U0); bf16* BR = (bf16*)(F.ws + WS_BR);
    LAS unsigned char* Ks = F.lds + SWA_KS; LAS unsigned char* Vs = F.lds + SWA_VS; const LAS float* tabr = (const LAS float*)(F.lds + SWA_TABR);
    const int q00 = qb4 * 256, lane = F.lane, fr = lane & 15, fq = lane >> 4;
    __syncthreads();
    { v4u tb[13];
#pragma unroll
      for (int i = 0; i < 13; ++i) { const int id = F.tid + 512 * i, which = id >= SWA_ROWS * 8, rem = id - which * (SWA_ROWS * 8), r = rem >> 3, ch = rem & 7; const int kp = q00 - 128 + r;
          tb[i] = (v4u){0u, 0u, 0u, 0u};
          if (id < 2 * SWA_ROWS * 8 && r < 384 && kp >= 0) tb[i] = *(const v4u*)(U0 + (size_t)(b * SEQ + kp) * N0 + 1536 + which * 256 + kvh * 64 + ch * 8); }
#pragma unroll
      for (int i = 0; i < 13; ++i) { const int id = F.tid + 512 * i, which = id >= SWA_ROWS * 8, rem = id - which * (SWA_ROWS * 8), r = rem >> 3, ch = rem & 7;
          if (id < 2 * SWA_ROWS * 8) *(LAS v4u*)((which ? Vs : Ks) + r * 144 + ch * 16) = tb[i]; } }
    __syncthreads();
    const float* sinks = F.in[10];
#pragma unroll 1
    for (int su = 0; su < 4; ++su) {
    const int q0 = q00 + 64 * su; LAS unsigned char* Ksu = Ks + su * 64 * 144; LAS unsigned char* Vsu = Vs + su * 64 * 144;
    bf16x8 qf[3][2]; v2u gv[3][4];
#pragma unroll
    for (int j = 0; j < 3; ++j) { const int gi = F.wave * 3 + j, head = kvh * 6 + (gi >> 2); const size_t qrow = (size_t)(b * SEQ + q0 + (gi & 3) * 16 + fr);
#pragma unroll
        for (int ks = 0; ks < 2; ++ks) qf[j][ks] = __builtin_nontemporal_load((const bf16x8*)(U0 + qrow * N0 + head * 64 + ks * 32 + fq * 8));
#pragma unroll
        for (int dt = 0; dt < 4; ++dt) gv[j][dt] = __builtin_nontemporal_load((const v2u*)(U0 + qrow * N0 + 2560 + head * 64 + 16 * dt + 4 * fq)); }
#pragma unroll
    for (int j = 0; j < 3; ++j) {
        const int gi = F.wave * 3 + j, g = gi >> 2, qsub = gi & 3, head = kvh * 6 + g, qs = q0 + qsub * 16;
        const size_t qrow = (size_t)(b * SEQ + qs + fr);
        f32x4 sacc[9];
#pragma unroll
        for (int T3 = 0; T3 < 3; ++T3) { bf16x8 kf[3][2];
#pragma unroll
            for (int t = 0; t < 3; ++t)
#pragma unroll
                for (int ks = 0; ks < 2; ++ks) kf[t][ks] = *(const LAS bf16x8*)(Ksu + (qsub * 16 + 16 * (3 * T3 + t) + fr) * 144 + (ks * 32 + fq * 8) * 2);
            __builtin_amdgcn_sched_barrier(0);
#pragma unroll
            for (int t = 0; t < 3; ++t) { f32x4 a = {0.f, 0.f, 0.f, 0.f};
#pragma unroll
                for (int ks = 0; ks < 2; ++ks) a = __builtin_amdgcn_mfma_f32_16x16x32_bf16(kf[t][ks], qf[j][ks], a, 0, 0, 0);
                sacc[3 * T3 + t] = a; }
            __builtin_amdgcn_sched_barrier(0); }
        const float L2E = 1.4426950408889634f; const float sink2 = sinks[head] * L2E; float mx = sink2;
        const LAS float* tb = tabr + head * TABR_LD + 15 - fr + 4 * fq; const int kmin = 128 - qs;
#pragma unroll
        for (int T = 0; T < 9; ++T) {
#pragma unroll
            for (int r = 0; r < 4; ++r) { float s = __builtin_fmaf(sacc[T][r], 0.125f * L2E, tb[16 * T + r]);
                if (T == 0) s = (4 * fq + r > fr) ? s : -INFINITY;
                if (T == 8) s = (4 * fq + r <= fr) ? s : -INFINITY;
                sacc[T][r] = s; }
            if (16 * T < kmin) sacc[T] = (f32x4){-INFINITY, -INFINITY, -INFINITY, -INFINITY};
            mx = fmaxf(mx, fmaxf(fmaxf(sacc[T][0], sacc[T][1]), fmaxf(sacc[T][2], sacc[T][3]))); }
        mx = fmaxf(mx, __shfl_xor(mx, 16)); mx = fmaxf(mx, __shfl_xor(mx, 32));
        float sum = 0.f;
#pragma unroll
        for (int T = 0; T < 9; ++T)
#pragma unroll
            for (int r = 0; r < 4; ++r) { const float p = __builtin_amdgcn_exp2f(sacc[T][r] - mx); sacc[T][r] = p; sum += p; }
        sum += __shfl_xor(sum, 16); sum += __shfl_xor(sum, 32);
        const float inv = 1.f / (sum + __builtin_amdgcn_exp2f(sink2 - mx));
        bf16x8 pf[5];
#pragma unroll
        for (int mm = 0; mm < 5; ++mm) { v4u w; w.x = pk2(sacc[2 * mm][0], sacc[2 * mm][1]); w.y = pk2(sacc[2 * mm][2], sacc[2 * mm][3]);
            if (mm < 4) { w.z = pk2(sacc[2 * mm + 1][0], sacc[2 * mm + 1][1]); w.w = pk2(sacc[2 * mm + 1][2], sacc[2 * mm + 1][3]); } else { w.z = 0u; w.w = 0u; }
            pf[mm] = __builtin_bit_cast(bf16x8, w); }
        f32x4 oacc[4];
#pragma unroll
        for (int d2 = 0; d2 < 2; ++d2) { s16x4 vlo[2][5], vhi[2][5];
#pragma unroll
            for (int t = 0; t < 2; ++t)
#pragma unroll
                for (int mm = 0; mm < 5; ++mm) { const LAS unsigned char* vp = Vsu + (qsub * 16 + 32 * mm + 4 * fq + (fr >> 2)) * 144 + (16 * (2 * d2 + t) + 4 * (fr & 3)) * 2; vlo[t][mm] = vtr(vp); vhi[t][mm] = vtr(vp + 16 * 144); }
            __builtin_amdgcn_sched_barrier(0);
#pragma unroll
            for (int t = 0; t < 2; ++t) { f32x4 a = {0.f, 0.f, 0.f, 0.f};
#pragma unroll
                for (int mm = 0; mm < 5; ++mm) { const bf16x8 vf = (bf16x8){vlo[t][mm][0], vlo[t][mm][1], vlo[t][mm][2], vlo[t][mm][3], vhi[t][mm][0], vhi[t][mm][1], vhi[t][mm][2], vhi[t][mm][3]};
                    a = __builtin_amdgcn_mfma_f32_16x16x32_bf16(vf, pf[mm], a, 0, 0, 0); }
                oacc[2 * d2 + t] = a; }
            __builtin_amdgcn_sched_barrier(0); }
#pragma unroll
        for (int dt = 0; dt < 4; ++dt) { const int col = head * 64 + 16 * dt + 4 * fq; const v2u g2 = gv[j][dt];
            const float g0 = bf2f((unsigned short)(g2.x & 0xffff)), g1 = bf2f((unsigned short)(g2.x >> 16)), g2f = bf2f((unsigned short)(g2.y & 0xffff)), g3 = bf2f((unsigned short)(g2.y >> 16));
            v2u o; o.x = pk2(oacc[dt][0] * inv * silu_f(g0), oacc[dt][1] * inv * silu_f(g1)); o.y = pk2(oacc[dt][2] * inv * silu_f(g2f), oacc[dt][3] * inv * silu_f(g3));
            *(v2u*)(BR + qrow * DM + col) = o; }
        asm volatile("" ::: "memory");
    }
    }
}

constexpr int MEM_KS = 0, MEM_VS = 256 * 272, MEM_VST = 288;
__device__ __forceinline__ void mem_prompt_unit(Frame& F, int layer, int b, int h, int qblk, const bf16* U, int ldu, int mq_col0, int gate_col0, int vflags = 0) {
    const bf16* MK = (const bf16*)(F.ws + WS_MKVB) + (size_t)layer * (2048 * 512); const bf16* MV = MK + (size_t)2 * (2048 * 512);
    bf16* BR = (bf16*)(F.ws + WS_BR);
    LAS unsigned char* Ks = F.lds + MEM_KS; LAS unsigned char* Vs = F.lds + MEM_VS;
    const int lane = F.lane, fr = lane & 15, fq = lane >> 4;
    bf16x8 qfa[2][4];
#pragma unroll
    for (int j = 0; j < 2; ++j) { const size_t qrow = (size_t)(b * SEQ + qblk * 256 + (F.wave * 2 + j) * 16 + fr);
#pragma unroll
        for (int ks = 0; ks < 4; ++ks) qfa[j][ks] = __builtin_nontemporal_load((const bf16x8*)(U + qrow * ldu + mq_col0 + h * 128 + ks * 32 + fq * 8)); }
    __syncthreads();
    if (!(vflags & 1024)) { v4u tb[16];
#pragma unroll
      for (int i = 0; i < 16; ++i) { const int id = F.tid + 512 * i, which = i >> 3, rem = id & 4095, r = rem >> 4, ch = rem & 15;
          tb[i] = *(const v4u*)((which ? MV : MK) + (size_t)(b * 256 + r) * 512 + h * 128 + ch * 8); }
#pragma unroll
      for (int i = 0; i < 16; ++i) { const int id = F.tid + 512 * i, which = i >> 3, rem = id & 4095, r = rem >> 4, ch = rem & 15;
          *(LAS v4u*)((which ? Vs + r * MEM_VST : Ks + r * 272) + ch * 16) = tb[i]; } }
    __syncthreads();
    const float cexp = 0.08838834764831845f * 1.4426950408889634f;
    if (vflags & 2048) return;
#define SB() __builtin_amdgcn_sched_barrier(0)
#pragma unroll
    for (int j = 0; j < 2; ++j) {
        const int qs = qblk * 256 + (F.wave * 2 + j) * 16; const size_t qrow = (size_t)(b * SEQ + qs + fr);
        v2u gva[8];
#pragma unroll
        for (int dt = 0; dt < 8; ++dt) gva[dt] = __builtin_nontemporal_load((const v2u*)(U + qrow * ldu + gate_col0 + 1536 + h * 128 + 16 * dt + 4 * fq));
        f32x4 sacc[16]; float mx = -INFINITY;
#pragma unroll
        for (int T2 = 0; T2 < 8; ++T2) { bf16x8 kf[2][4];
            if (vflags & 4096) { sacc[2 * T2] = (f32x4){0.f, 1.f, 2.f, 3.f}; sacc[2 * T2 + 1] = (f32x4){1.f, 0.f, 3.f, 2.f}; continue; }
#pragma unroll
            for (int t = 0; t < 2; ++t)
#pragma unroll
                for (int ks = 0; ks < 4; ++ks) kf[t][ks] = *(const LAS bf16x8*)(Ks + (16 * (2 * T2 + t) + fr) * 272 + (ks * 32 + fq * 8) * 2);
            SB();
#pragma unroll
            for (int t = 0; t < 2; ++t) { f32x4 a = {0.f, 0.f, 0.f, 0.f};
#pragma unroll
                for (int ks = 0; ks < 4; ++ks) a = __builtin_amdgcn_mfma_f32_16x16x32_bf16(kf[t][ks], qfa[j][ks], a, 0, 0, 0);
                sacc[2 * T2 + t] = a; }
            SB(); }
#pragma unroll
        for (int T = 0; T < 16; ++T) mx = fmaxf(mx, fmaxf(fmaxf(sacc[T][0], sacc[T][1]), fmaxf(sacc[T][2], sacc[T][3])));
        mx = fmaxf(mx, __shfl_xor(mx, 16)); mx = fmaxf(mx, __shfl_xor(mx, 32));
        const float nmx = -mx * cexp; float sum = 0.f; bf16x8 pf[8];
#pragma unroll
        for (int mm = 0; mm < 8; ++mm) { float p[8];
#pragma unroll
            for (int r = 0; r < 4; ++r) { if (vflags & 8192) { p[r] = sacc[2 * mm][r]; p[4 + r] = sacc[2 * mm + 1][r]; } else { p[r] = __builtin_amdgcn_exp2f(__builtin_fmaf(sacc[2 * mm][r], cexp, nmx)); p[4 + r] = __builtin_amdgcn_exp2f(__builtin_fmaf(sacc[2 * mm + 1][r], cexp, nmx)); } sum += p[r] + p[4 + r]; }
            v4u w; w.x = pk2(p[0], p[1]); w.y = pk2(p[2], p[3]); w.z = pk2(p[4], p[5]); w.w = pk2(p[6], p[7]); pf[mm] = __builtin_bit_cast(bf16x8, w); }
        sum += __shfl_xor(sum, 16); sum += __shfl_xor(sum, 32);
        const float inv = 1.f / sum;
#pragma unroll
        for (int d2 = 0; d2 < 4; ++d2) { s16x4 vlo[2][8], vhi[2][8];
            if (vflags & 16384) continue;
#pragma unroll
            for (int t = 0; t < 2; ++t)
#pragma unroll
                for (int mm = 0; mm < 8; ++mm) { const LAS unsigned char* vp = Vs + (32 * mm + 4 * fq + (fr >> 2)) * MEM_VST + (16 * (2 * d2 + t) + 4 * (fr & 3)) * 2; vlo[t][mm] = vtr(vp); vhi[t][mm] = vtr(vp + 16 * MEM_VST); }
            SB();
            f32x4 oacc[2];
#pragma unroll
            for (int t = 0; t < 2; ++t) { oacc[t] = (f32x4){0.f, 0.f, 0.f, 0.f};
#pragma unroll
                for (int mm = 0; mm < 8; ++mm) { const bf16x8 vf = (bf16x8){vlo[t][mm][0], vlo[t][mm][1], vlo[t][mm][2], vlo[t][mm][3], vhi[t][mm][0], vhi[t][mm][1], vhi[t][mm][2], vhi[t][mm][3]};
                    oacc[t] = __builtin_amdgcn_mfma_f32_16x16x32_bf16(vf, pf[mm], oacc[t], 0, 0, 0); } }
            SB();
#pragma unroll
            for (int t = 0; t < 2; ++t) { const int dt = 2 * d2 + t, col = h * 128 + 16 * dt + 4 * fq; const v2u gv = gva[dt];
                const float g0 = __uint_as_float(gv.x << 16), g1 = __uint_as_float(gv.x & 0xffff0000u), g2 = __uint_as_float(gv.y << 16), g3 = __uint_as_float(gv.y & 0xffff0000u);
                v2u o; o.x = pk2(oacc[t][0] * inv * silu_f(g0), oacc[t][1] * inv * silu_f(g1)); o.y = pk2(oacc[t][2] * inv * silu_f(g2), oacc[t][3] * inv * silu_f(g3));
                *(v2u*)(BR + qrow * DM + 1536 + col) = o; } }
    }
#undef SB
}

__device__ __forceinline__ void swa_sample_unit(Frame& F, int b, const LAS float* tab) {
    const bf16* U0 = (const bf16*)(F.ws + WS_U0); bf16* BR = (bf16*)(F.ws + WS_BR);
    LAS float* red = (LAS float*)(F.lds);
    LAS float* qf = (LAS float*)(F.lds + 73728);
    LAS float* kn = qf + 1536;
    LAS float* vn = kn + 256;
    LAS float* sc = vn + 256;
    LAS float* pinv = sc + 24 * 128;
    const size_t row = (size_t)(ROW_S + b);
    const float* ck = F.in[4] + (size_t)b * 128 * 256; const float* cv = F.in[5] + (size_t)b * 128 * 256;
    float* ok = F.out + O_SKS + (size_t)b * 128 * 256; float* ov = F.out + O_SVS + (size_t)b * 128 * 256;
    __syncthreads();
    for (int i = F.tid; i < 2048; i += 512) { const float v = bf2f(U0[row * N0 + i]); if (i < 1536) qf[i] = v; else if (i < 1792) kn[i - 1536] = v; else vn[i - 1792] = v; }
    __syncthreads();
    { const int j = F.tid >> 2, kvh = F.tid & 3; f32x4 kr[16];
#pragma unroll
      for (int c4 = 0; c4 < 16; ++c4) { if (j < 127) kr[c4] = __builtin_nontemporal_load((const f32x4*)(ck + (j + 1) * 256 + kvh * 64 + c4 * 4)); else kr[c4] = *(const LAS f32x4*)(kn + kvh * 64 + c4 * 4); }
      float acc[6] = {0.f, 0.f, 0.f, 0.f, 0.f, 0.f};
#pragma unroll
      for (int c4 = 0; c4 < 16; ++c4) { __builtin_nontemporal_store(kr[c4], (f32x4*)(ok + j * 256 + kvh * 64 + c4 * 4));
#pragma unroll
          for (int g = 0; g < 6; ++g) { const f32x4 q = *(const LAS f32x4*)(qf + (kvh * 6 + g) * 64 + c4 * 4); acc[g] += kr[c4].x * q.x + kr[c4].y * q.y + kr[c4].z * q.z + kr[c4].w * q.w; } }
#pragma unroll
      for (int g = 0; g < 6; ++g) { const int head = kvh * 6 + g; sc[head * 128 + j] = acc[g] * 0.125f + tab[head * 128 + (127 - j)]; } }
    const int vkvh = F.tid >> 7, jq = (F.tid >> 4) & 7, d4 = F.tid & 15; f32x4 vr[16];
#pragma unroll
    for (int i = 0; i < 16; ++i) { const int j = jq * 16 + i; if (j < 127) vr[i] = __builtin_nontemporal_load((const f32x4*)(cv + (j + 1) * 256 + vkvh * 64 + d4 * 4)); else vr[i] = *(const LAS f32x4*)(vn + vkvh * 64 + d4 * 4); }
    __syncthreads();
    for (int hh = 0; hh < 3; ++hh) { const int head = F.wave * 3 + hh; const float sink = F.in[10][head];
        const float s0 = sc[head * 128 + F.lane], s1 = sc[head * 128 + 64 + F.lane];
        const float mx = fmaxf(wave_max(fmaxf(s0, s1)), sink); const float p0 = __expf(s0 - mx), p1 = __expf(s1 - mx);
        const float sum = wave_sum(p0 + p1); sc[head * 128 + F.lane] = p0; sc[head * 128 + 64 + F.lane] = p1;
        if (F.lane == 0) pinv[head] = 1.f / (sum + __expf(sink - mx)); }
    __syncthreads();
    { f32x4 oa[6];
#pragma unroll
      for (int g = 0; g < 6; ++g) oa[g] = (f32x4){0.f, 0.f, 0.f, 0.f};
#pragma unroll
      for (int i = 0; i < 16; ++i) { const int j = jq * 16 + i; __builtin_nontemporal_store(vr[i], (f32x4*)(ov + j * 256 + vkvh * 64 + d4 * 4));
#pragma unroll
          for (int g = 0; g < 6; ++g) oa[g] += vr[i] * sc[(vkvh * 6 + g) * 128 + j]; }
#pragma unroll
      for (int g = 0; g < 6; ++g) *(LAS f32x4*)(red + (jq * 24 + vkvh * 6 + g) * 64 + d4 * 4) = oa[g]; }
    __syncthreads();
    for (int i = F.tid; i < 1536; i += 512) { const int head = i >> 6, d = i & 63; float o = 0.f;
#pragma unroll
        for (int q8 = 0; q8 < 8; ++q8) o += red[(q8 * 24 + head) * 64 + d];
        const float g = bf2f(U0[row * N0 + 2560 + i]);
        BR[row * DM + i] = f2bf(o * pinv[head] * silu_f(g)); }
}
__device__ __forceinline__ void mem_sample_unit(Frame& F, int layer, int b, int h, const bf16* U, int ldu, int mq_col0, int gate_col0) {
    bf16* BR = (bf16*)(F.ws + WS_BR);
    LAS float* sc = (LAS float*)(F.lds + 73728 + 32768);
    LAS float* red = sc + 256;
    const size_t row = (size_t)(ROW_S + b);
    const float* mk = F.in[2] + ((size_t)layer * NDEC + b) * (256 * 512) + h * 128; const float* mv = F.in[3] + ((size_t)layer * NDEC + b) * (256 * 512) + h * 128;
    const int half = F.lane >> 5, l32 = F.lane & 31, w = F.wave;
    const v2u qraw = *(const v2u*)(U + row * ldu + mq_col0 + h * 128 + l32 * 4);
    unsigned short graw = 0; if (F.tid < 128) graw = U[row * ldu + gate_col0 + 1536 + h * 128 + F.tid];
    f32x4 kv[16];
#pragma unroll
    for (int i = 0; i < 16; ++i) kv[i] = __builtin_nontemporal_load((const f32x4*)(mk + (size_t)(32 * w + 2 * i + half) * 512 + l32 * 4));
    __syncthreads();
    { const float sc0 = 0.08838834764831845f;
      const f32x4 qq = (f32x4){__uint_as_float(qraw.x << 16), __uint_as_float(qraw.x & 0xffff0000u), __uint_as_float(qraw.y << 16), __uint_as_float(qraw.y & 0xffff0000u)} * sc0;
#pragma unroll
      for (int i = 0; i < 16; ++i) { float p = kv[i].x * qq.x + kv[i].y * qq.y + kv[i].z * qq.z + kv[i].w * qq.w;
          p += __shfl_xor(p, 1); p += __shfl_xor(p, 2); p += __shfl_xor(p, 4); p += __shfl_xor(p, 8); p += __shfl_xor(p, 16);
          if (l32 == 0) sc[32 * w + 2 * i + half] = p; } }
    f32x4 vv[16];
#pragma unroll
    for (int i = 0; i < 16; ++i) vv[i] = __builtin_nontemporal_load((const f32x4*)(mv + (size_t)(32 * w + 2 * i + half) * 512 + l32 * 4));
    __syncthreads();
    if (w == 0) { float s[4]; float mx = -INFINITY;
#pragma unroll
        for (int i = 0; i < 4; ++i) { s[i] = sc[64 * i + F.lane]; mx = fmaxf(mx, s[i]); }
        mx = wave_max(mx); float sum = 0.f;
#pragma unroll
        for (int i = 0; i < 4; ++i) { s[i] = __expf(s[i] - mx); sum += s[i]; }
        sum = wave_sum(sum); const float inv = 1.f / sum;
#pragma unroll
        for (int i = 0; i < 4; ++i) sc[64 * i + F.lane] = s[i] * inv; }
    __syncthreads();
    { f32x4 o4 = {0.f, 0.f, 0.f, 0.f};
#pragma unroll
      for (int i = 0; i < 16; ++i) o4 += vv[i] * sc[32 * w + 2 * i + half];
      o4.x += __shfl_xor(o4.x, 32); o4.y += __shfl_xor(o4.y, 32); o4.z += __shfl_xor(o4.z, 32); o4.w += __shfl_xor(o4.w, 32);
      if (half == 0) *(LAS f32x4*)(red + w * 128 + l32 * 4) = o4; }
    __syncthreads();
    if (F.tid < 128) { float o = 0.f;
#pragma unroll
        for (int i = 0; i < 8; ++i) o += red[i * 128 + F.tid];
        BR[row * DM + 1536 + h * 128 + F.tid] = f2bf(o * silu_f(bf2f(graw))); }
}
__device__ __forceinline__ void hgrn_sample_unit(Frame& F, int b, int h) {
    const bf16* U1 = (const bf16*)(F.ws + WS_U1); bf16* BR = (bf16*)(F.ws + WS_BR);
    LAS float* qs = (LAS float*)(F.lds + 73728 + 49152);
    LAS float* fk = qs + 128; LAS float* kk = fk + 128; LAS float* vv = kk + 128; LAS float* red = vv + 128;
    LAS float* tot = red + 2048;
    const size_t row = (size_t)(ROW_S + b);
    const float* S0 = F.in[6] + ((size_t)b * 12 + h) * 16384; float* So = F.out + O_HSS + ((size_t)b * 12 + h) * 16384;
    const int c4 = F.tid & 31, kr = F.tid >> 5;
    f32x4 s4[8];
#pragma unroll
    for (int i = 0; i < 8; ++i) s4[i] = __builtin_nontemporal_load((const f32x4*)(S0 + (kr + 16 * i) * 128 + c4 * 4));
    unsigned short graw = 0, qraw = 0, fraw = 0, vraw = 0;
    if (F.tid < 128) { graw = U1[row * N1 + 5120 + h * 128 + F.tid]; qraw = U1[row * N1 + h * 128 + F.tid]; fraw = U1[row * N1 + 1536 + h * 128 + F.tid]; }
    else if (F.tid < 256) vraw = U1[row * N1 + 3072 + h * 128 + F.tid - 128];
    __syncthreads();
    if (F.tid < 128) { const int k = F.tid; const float l0 = F.in[12][h * 128 + k], l1 = F.in[12][1536 + h * 128 + k]; const float lb = fast_rcp(1.f + __expf(l0 - l1));
        const float fg = lb + (1.f - lb) * sigmoid_f(bf2f(fraw)); qs[k] = silu_f(bf2f(qraw)); fk[k] = fg; kk[k] = 1.f - fg; }
    else if (F.tid < 256) vv[F.tid - 128] = bf2f(vraw);
    __syncthreads();
    { const f32x4 v4 = *(const LAS f32x4*)(vv + c4 * 4); f32x4 o4 = {0.f, 0.f, 0.f, 0.f};
#pragma unroll
      for (int i = 0; i < 8; ++i) { const int k = kr + 16 * i; const f32x4 sn = s4[i] * fk[k] + v4 * kk[k];
          __builtin_nontemporal_store(sn, (f32x4*)(So + k * 128 + c4 * 4)); o4 += sn * qs[k]; }
      *(LAS f32x4*)(red + kr * 128 + c4 * 4) = o4; }
    __syncthreads();
    float o = 0.f;
    if (F.tid < 128) {
#pragma unroll
        for (int i = 0; i < 16; ++i) o += red[i * 128 + F.tid];
        const float ss = wave_sum(o * o); if (F.lane == 0) tot[F.wave] = ss; }
    __syncthreads();
    if (F.tid < 128) { const float rstd = 1.f / sqrtf((tot[0] + tot[1]) * (1.f / 128.f) + 1e-6f); const int c = h * 128 + F.tid;
        BR[row * DM + c] = f2bf(o * rstd * F.in[13][c] * silu_f(bf2f(graw))); }
}

constexpr int HG_REC = 41472, HGR_QG = 0, HGR_KDT = 16384, HGR_AS = 32768, HGR_EGL = 40960;
constexpr int HG_QG = 0, HG_QT = 17408, HG_KT = 34816, HG_VS = 52224, HG_KDT = 69632, HG_AS = 88064, HG_SEG = 97280, HG_EGL = 99328, HG_PART = 99840;
__device__ __forceinline__ float row16_sum(float v) {
    int x = __builtin_bit_cast(int, v);
    v += __builtin_bit_cast(float, __builtin_amdgcn_update_dpp(0, x, 0xB1, 0xF, 0xF, false)); x = __builtin_bit_cast(int, v);
    v += __builtin_bit_cast(float, __builtin_amdgcn_update_dpp(0, x, 0x4E, 0xF, 0xF, false)); x = __builtin_bit_cast(int, v);
    v += __builtin_bit_cast(float, __builtin_amdgcn_update_dpp(0, x, 0x141, 0xF, 0xF, false)); x = __builtin_bit_cast(int, v);
    v += __builtin_bit_cast(float, __builtin_amdgcn_update_dpp(0, x, 0x140, 0xF, 0xF, false));
    return v;
}
__device__ __forceinline__ void hgrn_prep_phase(Frame& F) {
    const bf16* U1 = (const bf16*)(F.ws + WS_U1); unsigned char* HG = F.ws + WS_HG;
    LAS unsigned char* L = F.lds; LAS float* SEG = (LAS float*)(L + HG_SEG);
    const int tid = F.tid, lane = F.lane, w = F.wave, fr = lane & 15, fq = lane >> 4;
    const int k = tid & 127, tq = tid >> 7;
    const float L2E = 1.4426950408889634f;
    unsigned short nqr[16], nfr[16];
#define HGP_LOAD(id_) do { const int bh_ = (id_) >> 5, c_ = (id_) & 31, b_ = bh_ / 12, h_ = bh_ % 12; const size_t r0_ = (size_t)b_ * SEQ + c_ * 64 + tq * 16; \
        _Pragma("unroll") for (int i = 0; i < 16; ++i) { nqr[i] = __builtin_nontemporal_load(U1 + (r0_ + i) * N1 + h_ * 128 + k); nfr[i] = __builtin_nontemporal_load(U1 + (r0_ + i) * N1 + 1536 + h_ * 128 + k); } } while (0)
    int id = F.bid;
    if (id < NB * 12 * 32) HGP_LOAD(id);
    __syncthreads();
#pragma unroll 1
    for (; id < NB * 12 * 32; id += F.G) {
        const int bh = id >> 5, h = bh % 12;
        unsigned char* rec = HG + (size_t)id * HG_REC;
        float lbk; { const float l0 = F.in[12][h * 128 + k], l1 = F.in[12][1536 + h * 128 + k]; lbk = fast_rcp(1.f + __expf(l0 - l1)); }
        const float oml = 1.f - lbk;
        float gl[16], qv[16], kv[16]; float run = 0.f;
#pragma unroll
        for (int i = 0; i < 16; ++i) { const float f = bf2f(nfr[i]), q = bf2f(nqr[i]);
            const float sg = fast_rcp(1.f + __builtin_amdgcn_exp2f(-L2E * f)); const float fg = __builtin_fmaf(sg, oml, lbk);
            run += __builtin_amdgcn_logf(fg); gl[i] = run; kv[i] = 1.f - fg; qv[i] = q * fast_rcp(1.f + __builtin_amdgcn_exp2f(-L2E * q)); }
        SEG[tq * 128 + k] = run;
        if (id + F.G < NB * 12 * 32) HGP_LOAD(id + F.G);
        LDS_BARRIER();
        const float s0 = SEG[k], s1 = SEG[128 + k], s2 = SEG[256 + k], s3 = SEG[384 + k];
        const float gmid = s0 + s1, glast = gmid + s2 + s3;
        const float basem = ((tq == 0) ? 0.f : (tq == 1) ? s0 : (tq == 2) ? gmid : gmid + s2) - gmid;
        const float egm = __builtin_amdgcn_exp2f(gmid), eglm = __builtin_amdgcn_exp2f(glast - gmid);
        if (tq == 0) *(float*)(rec + HGR_EGL + 4 * k) = __builtin_amdgcn_exp2f(glast);
        { unsigned kd[8];
#pragma unroll
          for (int i = 0; i < 16; ++i) { const int t = tq * 16 + i; const float x = __builtin_amdgcn_fmed3f(basem + gl[i], -115.f, 115.f);
              const float e1 = __builtin_amdgcn_exp2f(x), e2 = fast_rcp(e1); const float qt = qv[i] * e1, kt = kv[i] * e2;
              const unsigned pq = pk2(qt, qt * egm);
              *(LAS unsigned short*)(L + HG_QT + t * 272 + k * 2) = (unsigned short)(pq & 0xffffu);
              *(LAS unsigned short*)(L + HG_QG + t * 272 + k * 2) = (unsigned short)(pq >> 16);
              const unsigned pkk = pk2(kt, kt * eglm);
              *(LAS unsigned short*)(L + HG_KT + t * 272 + k * 2) = (unsigned short)(pkk & 0xffffu);
              if (i & 1) kd[i >> 1] |= (pkk & 0xffff0000u); else kd[i >> 1] = pkk >> 16; }
          *(LAS v4u*)(L + HG_KDT + k * 144 + tq * 32) = (v4u){kd[0], kd[1], kd[2], kd[3]};
          *(LAS v4u*)(L + HG_KDT + k * 144 + tq * 32 + 16) = (v4u){kd[4], kd[5], kd[6], kd[7]}; }
        LDS_BARRIER();
#pragma unroll
        for (int jj = 0; jj < 2; ++jj) { const int tile = 2 * w + jj, tt = tile >> 2, ts = tile & 3; f32x4 a = {0.f, 0.f, 0.f, 0.f};
            if (ts <= tt) {
#pragma unroll
                for (int ks = 0; ks < 4; ++ks) { const bf16x8 af = *(const LAS bf16x8*)(L + HG_QT + (16 * tt + fr) * 272 + (32 * ks + 8 * fq) * 2);
                    const bf16x8 bfv = *(const LAS bf16x8*)(L + HG_KT + (16 * ts + fr) * 272 + (32 * ks + 8 * fq) * 2);
                    a = __builtin_amdgcn_mfma_f32_16x16x32_bf16(af, bfv, a, 0, 0, 0); } }
#pragma unroll
            for (int r = 0; r < 4; ++r) { const int t = 16 * tt + 4 * fq + r, s = 16 * ts + fr; const float v = (ts <= tt && s <= t) ? a[r] : 0.f;
                *(LAS unsigned short*)(L + HG_AS + t * 144 + s * 2) = f2bf(v); } }
        LDS_BARRIER();
#pragma unroll
        for (int i = 0; i < 2; ++i) { const int p = tid + 512 * i, r = p >> 4; *(v4u*)(rec + HGR_QG + p * 16) = *(const LAS v4u*)(L + HG_QG + r * 272 + ((p & 15) ^ (r & 15)) * 16); }
#pragma unroll
        for (int i = 0; i < 2; ++i) { const int p = tid + 512 * i, r = p >> 3; *(v4u*)(rec + HGR_KDT + p * 16) = *(const LAS v4u*)(L + HG_KDT + r * 144 + ((p & 7) ^ (r & 7)) * 16); }
        { const int p = tid, r = p >> 3; *(v4u*)(rec + HGR_AS + p * 16) = *(const LAS v4u*)(L + HG_AS + r * 144 + ((p & 7) ^ (r & 7)) * 16); }
        LDS_BARRIER();
    }
#undef HGP_LOAD
}
constexpr int SQ_BUF = 57344, SQ_QG = 0, SQ_KDT = 16384, SQ_AS = 32768, SQ_V = 40960;
constexpr int SQ_GT = 114688, SQ_EGL = 132096, SQ_RSTD = 132608, SQ_PART = 132864;
struct HgStage { v4u g[2]; f32x4 egl; };
__device__ __forceinline__ void hgs_dma(LAS unsigned char* Lb, const unsigned char* rec, const bf16* U1row0, int h, int w, int lane) {
    typedef const __attribute__((address_space(1))) unsigned* gu;
#pragma unroll
    for (int i = 0; i < 2; ++i) { const int q = 2 * w + i;
        __builtin_amdgcn_global_load_lds((gu)(rec + HGR_QG + q * 1024 + lane * 16), (LAS unsigned*)(Lb + SQ_QG + q * 1024), 16, 0, 0);
        __builtin_amdgcn_global_load_lds((gu)(rec + HGR_KDT + q * 1024 + lane * 16), (LAS unsigned*)(Lb + SQ_KDT + q * 1024), 16, 0, 0);
        const int r = 4 * q + (lane >> 4), c = (lane & 15) ^ (r & 15);
        __builtin_amdgcn_global_load_lds((gu)(U1row0 + (size_t)r * N1 + 3072 + h * 128 + c * 8), (LAS unsigned*)(Lb + SQ_V + q * 1024), 16, 0, 0); }
    __builtin_amdgcn_global_load_lds((gu)(rec + HGR_AS + w * 1024 + lane * 16), (LAS unsigned*)(Lb + SQ_AS + w * 1024), 16, 0, 0);
}
__device__ __forceinline__ void hgs_load(HgStage& S, const unsigned char* rec, const bf16* U1row0, int h, int tid) {
    typedef const __attribute__((address_space(1))) v4u* g4; typedef const __attribute__((address_space(1))) f32x4* gf4;
    const bf16* gp = U1row0 + (size_t)(tid >> 4) * N1 + 5120 + h * 128 + (tid & 15) * 8;
    S.g[0] = __builtin_nontemporal_load((g4)gp); S.g[1] = __builtin_nontemporal_load((g4)(gp + (size_t)32 * N1));
    if (tid < 32) S.egl = *(gf4)(rec + HGR_EGL + tid * 16);
}
struct SqAddr { unsigned qg[4][2], as[2], kd[2], vt[2][2]; };
__device__ __forceinline__ void hgs_compute(f32x4 (&Sacc)[8], LAS unsigned char* L, LAS unsigned char* Lb, const SqAddr& A, v2u (&pend)[4], const f32x4 nw4, int tid, int w, int fr, int fq) {
    LAS float* EGL = (LAS float*)(L + SQ_EGL); LAS float* PART = (LAS float*)(L + SQ_PART); LAS float* RSTD = (LAS float*)(L + SQ_RSTD); const int dv0 = 16 * w;
#define SB() __builtin_amdgcn_sched_barrier(0)
    bf16x8 vf[2]; f32x4 o[4];
    { bf16x8 as[4][2];
#pragma unroll
      for (int ks = 0; ks < 2; ++ks) { const s16x4 lo = vtr(Lb + A.vt[ks][0]), hi = vtr(Lb + A.vt[ks][1]); vf[ks] = (bf16x8){lo[0], lo[1], lo[2], lo[3], hi[0], hi[1], hi[2], hi[3]}; }
#pragma unroll
      for (int tt = 0; tt < 4; ++tt)
#pragma unroll
          for (int ks = 0; ks < 2; ++ks) as[tt][ks] = *(const LAS bf16x8*)(Lb + A.as[ks] + tt * 2048);
      SB();
#pragma unroll
      for (int tt = 0; tt < 4; ++tt) { o[tt] = (f32x4){0.f, 0.f, 0.f, 0.f};
#pragma unroll
          for (int ks = 0; ks < 2; ++ks) o[tt] = __builtin_amdgcn_mfma_f32_16x16x32_bf16(vf[ks], as[tt][ks], o[tt], 0, 0, 0); }
      SB(); }
    bf16x8 sb[4];
#pragma unroll
    for (int mm = 0; mm < 4; ++mm) { v4u wv; wv.x = pk2(Sacc[2 * mm][0], Sacc[2 * mm][1]); wv.y = pk2(Sacc[2 * mm][2], Sacc[2 * mm][3]);
        wv.z = pk2(Sacc[2 * mm + 1][0], Sacc[2 * mm + 1][1]); wv.w = pk2(Sacc[2 * mm + 1][2], Sacc[2 * mm + 1][3]); sb[mm] = __builtin_bit_cast(bf16x8, wv); }
#pragma unroll
    for (int hh = 0; hh < 2; ++hh) { v2u qa[2][4][2];
#pragma unroll
        for (int t2 = 0; t2 < 2; ++t2)
#pragma unroll
            for (int mm = 0; mm < 4; ++mm) { qa[t2][mm][0] = *(const LAS v2u*)(Lb + A.qg[mm][0] + (2 * hh + t2) * 4096); qa[t2][mm][1] = *(const LAS v2u*)(Lb + A.qg[mm][1] + (2 * hh + t2) * 4096); }
        SB();
#pragma unroll
        for (int t2 = 0; t2 < 2; ++t2)
#pragma unroll
            for (int mm = 0; mm < 4; ++mm) o[2 * hh + t2] = __builtin_amdgcn_mfma_f32_16x16x32_bf16(sb[mm], __builtin_bit_cast(bf16x8, (v4u){qa[t2][mm][0].x, qa[t2][mm][0].y, qa[t2][mm][1].x, qa[t2][mm][1].y}), o[2 * hh + t2], 0, 0, 0);
        SB(); }
#pragma unroll
    for (int hh = 0; hh < 2; ++hh) { bf16x8 ka[4][2]; f32x4 ega[4];
#pragma unroll
        for (int T = 0; T < 4; ++T) { ega[T] = *(const LAS f32x4*)(EGL + 16 * (4 * hh + T) + 4 * fq);
#pragma unroll
            for (int ks = 0; ks < 2; ++ks) ka[T][ks] = *(const LAS bf16x8*)(Lb + A.kd[ks] + (4 * hh + T) * 2048); }
        SB();
#pragma unroll
        for (int T = 0; T < 4; ++T) { f32x4 acc = Sacc[4 * hh + T] * ega[T];
#pragma unroll
            for (int ks = 0; ks < 2; ++ks) acc = __builtin_amdgcn_mfma_f32_16x16x32_bf16(ka[T][ks], vf[ks], acc, 0, 0, 0);
            Sacc[4 * hh + T] = acc; }
        SB(); }
#undef SB
#pragma unroll
    for (int tt = 0; tt < 4; ++tt) { const f32x4 q = o[tt] * o[tt]; PART[(16 * tt + fr) * 32 + 4 * w + fq] = (q.x + q.y) + (q.z + q.w); }
    LDS_BARRIER();
    { const int t = tid >> 3, j = tid & 7; const f32x4 p = *(const LAS f32x4*)(PART + t * 32 + 4 * j); float s = (p.x + p.y) + (p.z + p.w);
      int x = __builtin_bit_cast(int, s);
      s += __builtin_bit_cast(float, __builtin_amdgcn_update_dpp(0, x, 0xB1, 0xF, 0xF, false)); x = __builtin_bit_cast(int, s);
      s += __builtin_bit_cast(float, __builtin_amdgcn_update_dpp(0, x, 0x4E, 0xF, 0xF, false)); x = __builtin_bit_cast(int, s);
      s += __builtin_bit_cast(float, __builtin_amdgcn_update_dpp(0, x, 0x141, 0xF, 0xF, false));
      if (j == 0) RSTD[t] = __builtin_amdgcn_rsqf(s * (1.f / 128.f) + 1e-6f); }
    LDS_BARRIER();
#pragma unroll
    for (int tt = 0; tt < 4; ++tt) { const int t = 16 * tt + fr; const float rstd = RSTD[t]; const v2u g2 = *(const LAS v2u*)(L + SQ_GT + t * 272 + (dv0 + 4 * fq) * 2);
        const float g0 = __uint_as_float(g2.x << 16), g1 = __uint_as_float(g2.x & 0xffff0000u), g2f = __uint_as_float(g2.y << 16), g3 = __uint_as_float(g2.y & 0xffff0000u);
        const f32x4 y = o[tt] * rstd * nw4;
        pend[tt].x = pk2(y.x * silu_f(g0), y.y * silu_f(g1)); pend[tt].y = pk2(y.z * silu_f(g2f), y.w * silu_f(g3)); }
}
__device__ __forceinline__ void hgrn_seq_unit(Frame& F, int b, int h, int vflags) {
    const bf16* U1 = (const bf16*)(F.ws + WS_U1); bf16* BR = (bf16*)(F.ws + WS_BR); const unsigned char* HG = F.ws + WS_HG + (size_t)(b * 12 + h) * 32 * HG_REC;
    LAS unsigned char* L = F.lds;
    const int tid = F.tid, lane = F.lane, w = F.wave, fr = lane & 15, fq = lane >> 4;
    const f32x4 nw4 = *(const f32x4*)(F.in[13] + h * 128 + 16 * w + 4 * fq);
    SqAddr A;
#pragma unroll
    for (int mm = 0; mm < 4; ++mm)
#pragma unroll
        for (int hf = 0; hf < 2; ++hf) A.qg[mm][hf] = SQ_QG + fr * 256 + (((4 * mm + (fq >> 1) + 2 * hf) ^ fr) << 4) + 8 * (fq & 1);
#pragma unroll
    for (int ks = 0; ks < 2; ++ks) { A.as[ks] = SQ_AS + fr * 128 + (((4 * ks + fq) ^ (fr & 7)) << 4); A.kd[ks] = SQ_KDT + fr * 128 + (((4 * ks + fq) ^ (fr & 7)) << 4);
#pragma unroll
        for (int hf = 0; hf < 2; ++hf) { const int R = 32 * ks + 8 * fq + (fr >> 2) + 4 * hf; A.vt[ks][hf] = SQ_V + R * 256 + (((2 * w + ((fr & 3) >> 1)) ^ (R & 15)) << 4) + 8 * (fr & 1); } }
    f32x4 Sacc[8];
#pragma unroll
    for (int T = 0; T < 8; ++T) Sacc[T] = (f32x4){0.f, 0.f, 0.f, 0.f};
    HgStage S; S.egl = (f32x4){0.f, 0.f, 0.f, 0.f};
    v2u pend[4];
#pragma unroll
    for (int i = 0; i < 4; ++i) pend[i] = (v2u){0u, 0u};
    __syncthreads();
    hgs_dma(L, HG, U1 + (size_t)b * SEQ * N1, h, w, lane); hgs_load(S, HG, U1 + (size_t)b * SEQ * N1, h, tid);
#pragma unroll 1
    for (int c = 0; c < 32; ++c) {
        LAS unsigned char* Lb = L + (c & 1) * SQ_BUF;
        asm volatile("s_waitcnt vmcnt(0)" ::: "memory");
        LDS_BARRIER();
        { const int r = tid >> 4, ch = tid & 15; *(LAS v4u*)(L + SQ_GT + r * 272 + ch * 16) = S.g[0]; *(LAS v4u*)(L + SQ_GT + (32 + r) * 272 + ch * 16) = S.g[1];
          if (tid < 32) *(LAS f32x4*)(L + SQ_EGL + tid * 16) = S.egl; }
        if (c > 0) { bf16* op = BR + ((size_t)b * SEQ + (c - 1) * 64 + fr) * DM + h * 128 + 16 * w + 4 * fq;
#pragma unroll
            for (int tt = 0; tt < 4; ++tt) *(v2u*)(op + (size_t)(16 * tt) * DM) = pend[tt]; }
        if (c + 1 < 32) { const bf16* u1n = U1 + ((size_t)b * SEQ + (c + 1) * 64) * N1; const unsigned char* recn = HG + (size_t)(c + 1) * HG_REC;
            hgs_dma(L + ((c + 1) & 1) * SQ_BUF, recn, u1n, h, w, lane); hgs_load(S, recn, u1n, h, tid); }
        LDS_BARRIER();
        hgs_compute(Sacc, L, Lb, A, pend, nw4, tid, w, fr, fq);
    }
    { bf16* op = BR + ((size_t)b * SEQ + 31 * 64 + fr) * DM + h * 128 + 16 * w + 4 * fq;
#pragma unroll
      for (int tt = 0; tt < 4; ++tt) *(v2u*)(op + (size_t)(16 * tt) * DM) = pend[tt]; }
    float* So = F.out + O_HSP + ((size_t)b * 12 + h) * 16384;
#pragma unroll
    for (int T = 0; T < 8; ++T)
#pragma unroll
        for (int r = 0; r < 4; ++r) __builtin_nontemporal_store(Sacc[T][r], So + (16 * T + 4 * fq + r) * 128 + 16 * w + fr);
}

struct SkStoreProj { bf16* U; int ldu;
    __device__ __forceinline__ void operator()(int row, int col, f32x4 v) const { v2u o; o.x = pk2(v.x, v.y); o.y = pk2(v.z, v.w); *(v2u*)(U + (size_t)(ROW_S + row) * ldu + col) = o; } };
struct SkStoreOut { bf16* Z; int mode; const bf16* xb; const bf16* zprev; const float* stats; const float* lnw; const float* lnb;
    __device__ __forceinline__ void operator()(int row, int col, f32x4 v) const { const size_t ro = (size_t)(ROW_S + row) * DM + col; const v2u q = *(const v2u*)((mode == 0 ? xb : zprev) + ro);
        f32x4 r = (f32x4){__uint_as_float(q.x << 16), __uint_as_float(q.x & 0xffff0000u), __uint_as_float(q.y << 16), __uint_as_float(q.y & 0xffff0000u)};
        if (mode == 1) { const float mu = stats[2 * (ROW_S + row)], rs = stats[2 * (ROW_S + row) + 1]; r = (r - mu) * rs * *(const f32x4*)(lnw + col) + *(const f32x4*)(lnb + col); }
        const f32x4 y = r * ALPHA + v; v2u o; o.x = pk2(y.x, y.y); o.y = pk2(y.z, y.w); *(v2u*)(Z + ro) = o; } };
template <class Store>
__device__ __forceinline__ void skinny_unit(Frame& F, const bf16* A, const bf16* Bt, int n0, const Store& st) {
    const int lane = F.lane, fr = lane & 15, fq = lane >> 4, w = F.wave;
    f32x4 acc[8][2];
#pragma unroll
    for (int m = 0; m < 8; ++m) { acc[m][0] = (f32x4){0.f, 0.f, 0.f, 0.f}; acc[m][1] = (f32x4){0.f, 0.f, 0.f, 0.f}; }
    const bf16* ap = A + (size_t)fr * DM + 256 * w + 8 * fq; const bf16* bp = Bt + (size_t)(n0 + fr) * DM + 256 * w + 8 * fq;
#pragma unroll 4
    for (int ks = 0; ks < 8; ++ks) { bf16x8 bfr[2], afr[8];
#pragma unroll
        for (int n = 0; n < 2; ++n) bfr[n] = *(const bf16x8*)(bp + (size_t)n * 16 * DM + ks * 32);
#pragma unroll
        for (int m = 0; m < 8; ++m) afr[m] = *(const bf16x8*)(ap + (size_t)m * 16 * DM + ks * 32);
#pragma unroll
        for (int m = 0; m < 8; ++m)
#pragma unroll
            for (int n = 0; n < 2; ++n) acc[m][n] = __builtin_amdgcn_mfma_f32_16x16x32_bf16(bfr[n], afr[m], acc[m][n], 0, 0, 0); }
    LAS f32x4* red = (LAS f32x4*)F.lds;
    __syncthreads();
#pragma unroll
    for (int m = 0; m < 8; ++m)
#pragma unroll
        for (int n = 0; n < 2; ++n) red[(w * 16 + m * 2 + n) * 64 + lane] = acc[m][n];
    __syncthreads();
#pragma unroll
    for (int n = 0; n < 2; ++n) { f32x4 s = {0.f, 0.f, 0.f, 0.f};
#pragma unroll
        for (int ww = 0; ww < 8; ++ww) s += red[(ww * 16 + w * 2 + n) * 64 + lane];
        st(16 * w + fr, n0 + 16 * n + 4 * fq, s); }
}
template <class Store>
__device__ __forceinline__ void skinny_phase(Frame& F, const bf16* A, const bf16* Bt, int N, int span, const Store& st) {
    if (span > F.G) span = F.G;
    const int first = F.G - 1 - F.bid; if (first >= span) return;
    for (int u = first; u < N / 32; u += span) skinny_unit(F, A, Bt, 32 * u, st);
}

#define XB_TMO      128
#define XB_XCNT(j)  (256  + 64 * (j))
#define XB_XSUB(j)  (1280 + 64 * (j))
#define XB_XGEN(j)  (2304 + 64 * (j))
#define XB_TOP      3328
#define XB_TOPGEN   3392
#define XCD_BAR_WORDS 3456
#define XB_SPIN_CAP (1u << 18)

__device__ __forceinline__ unsigned xb_ld(unsigned* p)              { return __hip_atomic_load(p, __ATOMIC_RELAXED, __HIP_MEMORY_SCOPE_AGENT); }
__device__ __forceinline__ unsigned xb_add(unsigned* p, unsigned v) { return __hip_atomic_fetch_add(p, v, __ATOMIC_RELAXED, __HIP_MEMORY_SCOPE_AGENT); }
__device__ __forceinline__ unsigned xb_xcc_id() { return (unsigned)__builtin_amdgcn_s_getreg((3 << 11) | 20) & 0xFu; }
#define XB_SPIN(cond, bar) do { unsigned _sp = 0; while (cond) { __builtin_amdgcn_s_sleep(1); \
    if ((++_sp & 255u) == 0u) { if (xb_ld(&(bar)[XB_TMO])) break; if (_sp > XB_SPIN_CAP) { atomicAdd(&(bar)[XB_TMO], 1u); break; } } } } while (0)

struct XcdBarrier {
    unsigned* bar; unsigned x;
    volatile LAS unsigned* st;
};

__device__ __forceinline__ XcdBarrier xcd_barrier_post(unsigned* bar, volatile LAS unsigned* st) {
    XcdBarrier b; b.bar = bar; b.x = xb_xcc_id(); b.st = st;
    if (threadIdx.x == 0) (void)xb_add(&bar[XB_XCNT(b.x)], 1u);
    return b;
}
__device__ __forceinline__ void xcd_barrier_complete(unsigned* bar, unsigned x, unsigned& nloc, unsigned& nx) {
    const unsigned G = gridDim.x * gridDim.y * gridDim.z;
    unsigned sum, cnt, mine, sp = 0u;
    for (;;) {
        sum = 0u; cnt = 0u; mine = 0u;
#pragma unroll
        for (unsigned j = 0; j < 16; ++j) { const unsigned c = xb_ld(&bar[XB_XCNT(j)]); sum += c; cnt += (c > 0u) ? 1u : 0u; mine = (j == x) ? c : mine; }
        if (sum == G) break;
        __builtin_amdgcn_s_sleep(1);
        if ((++sp & 255u) == 0u) { if (xb_ld(&bar[XB_TMO])) break; if (sp > XB_SPIN_CAP) { atomicAdd(&bar[XB_TMO], 1u); break; } }
    }
    nloc = mine > 0u ? mine : 1u; nx = cnt > 0u ? cnt : 1u;
}

__device__ __forceinline__ void xcd_barrier(const XcdBarrier& b) {
    asm volatile("s_waitcnt vmcnt(0)" ::: "memory");
    __syncthreads();
    if (threadIdx.x == 0) {
        unsigned* bar = b.bar;
        __builtin_amdgcn_s_waitcnt(0);
        unsigned nloc = b.st[0], nx = b.st[1];
        if (nloc == 0u) { xcd_barrier_complete(bar, b.x, nloc, nx); b.st[0] = nloc; b.st[1] = nx; }
        const unsigned old = xb_add(&bar[XB_XSUB(b.x)], 1u);
        const unsigned gen = old / nloc;
        if (old + 1u == (gen + 1u) * nloc) {
            __builtin_amdgcn_fence(__ATOMIC_RELEASE, "agent");
            asm volatile("s_waitcnt vmcnt(0)" ::: "memory");
            const unsigned og = xb_add(&bar[XB_TOP], 1u);
            const unsigned tg = og / nx;
            if (og + 1u == (tg + 1u) * nx) xb_add(&bar[XB_TOPGEN], 1u);
            else XB_SPIN(xb_ld(&bar[XB_TOPGEN]) == tg, bar);
            __builtin_amdgcn_fence(__ATOMIC_ACQUIRE, "agent");
            xb_add(&bar[XB_XGEN(b.x)], 1u);
            asm volatile("s_waitcnt vmcnt(0)" ::: "memory");
        } else {
            XB_SPIN(xb_ld(&bar[XB_XGEN(b.x)]) == gen, bar);
            __builtin_amdgcn_fence(__ATOMIC_ACQUIRE, "agent");
            asm volatile("s_waitcnt vmcnt(0)" ::: "memory");
        }
    }
    __syncthreads();
}

constexpr int LDS_MISC = LDS_BYTES - 256;
constexpr size_t CTL_ZERO_BYTES = 262144;
struct Args { const float* in[19]; float* out; unsigned char* ws; int ph_lo, ph_hi, li, flags; };
constexpr int N_PHASES = 10;
#ifndef MK_PLAN
#define MK_PLAN 0
#endif

__global__ void __launch_bounds__(512, 2) fwd_megakernel(Args args) {
    extern __shared__ __attribute__((aligned(16))) unsigned char lds_raw[];
    Frame F;
    F.lds = (LAS unsigned char*)lds_raw;
    F.tid = threadIdx.x; F.lane = F.tid & 63; F.wave = __builtin_amdgcn_readfirstlane(F.tid >> 6);
    F.G = gridDim.x; F.bid = blockIdx.x;
#pragma unroll
    for (int i = 0; i < 19; ++i) F.in[i] = args.in[i];
    F.out = args.out; F.ws = args.ws;
    const int lo = args.ph_lo, hi = args.ph_hi, fl = args.flags;
    if (F.tid < 64) ((LAS unsigned*)(F.lds + LDS_MISC))[F.tid] = 0u;
    __syncthreads();
    XcdBarrier bar = xcd_barrier_post((unsigned*)(F.ws + WS_CTL) + 1024 + args.li * 4096, (volatile LAS unsigned*)(F.lds + LDS_MISC));
#define IN(k) (lo <= (k) && (k) < hi)
#define SEAM(k) do { if (IN(k) && IN((k) + 1)) { xcd_barrier(bar); } } while (0)
    const int gw = F.bid * 8 + F.wave, NGW = F.G * 8;
    bf16* A0 = (bf16*)(F.ws + WS_A0); bf16* U0 = (bf16*)(F.ws + WS_U0); bf16* U1 = (bf16*)(F.ws + WS_U1); bf16* BR = (bf16*)(F.ws + WS_BR);
    bf16* H1 = (bf16*)(F.ws + WS_H1); bf16* Z0 = (bf16*)(F.ws + WS_Z0); bf16* Z1 = (bf16*)(F.ws + WS_Z1); float* STATS = (float*)(F.ws + WS_MISC);
    bf16* WT0 = (bf16*)(F.ws + WS_WT0); bf16* WT1 = (bf16*)(F.ws + WS_WT1); bf16* WO = (bf16*)(F.ws + WS_WO); bf16* MKVB = (bf16*)(F.ws + WS_MKVB);

    if (IN(0)) { p0_prologue(F); }
    SEAM(0);
    if (IN(1)) {
        pg8::Gemm g{A0, WT0, A0_ROWS, N0 + 2048, DM};
        pg8::OrderExt S; S.init(NTOK, N0, F.G, F.bid, 64, ROWS_ACT / 256, N0 / 256, 8);
        pg8::EpiProj E{U0, N0, N0 / 256, ROWS_ACT / 256, F.out + O_MK, MKVB};
        pg8::gemm_phase<pg8::EpiProj, pg8::OrderExt, true, true>(F.lds, g, S, E);
        skinny_phase(F, A0 + (size_t)ROW_S * DM, WT0, N0, 64, SkStoreProj{U0, N0});
    }
    SEAM(1);
    if (IN(2)) {
        LAS float* tab = (LAS float*)(F.lds + SWA_TAB);
        __syncthreads(); build_bias_tab(F, tab); __syncthreads(); build_bias_tabr(F, tab, (LAS float*)(F.lds + SWA_TABR)); __syncthreads();
        if (!(fl & 4)) for (int id = F.bid; id < 256; id += F.G) { const int b = id >> 5, rem = id & 31; swa_prompt_unit(F, b, rem >> 3, rem & 7); }
        if (!(fl & 16)) for (int b = F.bid; b < NDEC; b += F.G) swa_sample_unit(F, b, tab);
        if (!(fl & 8)) for (int id = F.bid; id < 256; id += F.G) { const int b = id >> 5, rem = id & 31; mem_prompt_unit(F, 0, b, rem >> 3, rem & 7, U0, N0, 2048, 2560, fl); }
        if (!(fl & 32)) {
            if (F.G == 256) { if (F.bid < 128) mem_sample_unit(F, 0, F.bid >> 2, F.bid & 3, U0, N0, 2048, 2560);
                else for (int k3 = 0; k3 < 3; ++k3) { const int u = 128 + (F.bid - 128) * 3 + k3; mem_sample_unit(F, 0, u >> 2, u & 3, U0, N0, 2048, 2560); } }
            else for (int u = F.G - 1 - F.bid; u < NDEC * 4; u += F.G) mem_sample_unit(F, 0, u >> 2, u & 3, U0, N0, 2048, 2560); }
        for (int i = F.bid * 512 + F.tid; i < NB * 128 * 512; i += F.G * 512) { const int b = i >> 16, r = (i >> 9) & 127, c = i & 511;
            const float v = bf2f(U0[(size_t)(b * SEQ + SEQ - 128 + r) * N0 + 1536 + c]);
            if (c < 256) F.out[O_SKP + (size_t)(b * 128 + r) * 256 + c] = v; else F.out[O_SVP + (size_t)(b * 128 + r) * 256 + (c - 256)] = v; }
    }
    SEAM(2);
    if (IN(3)) {
        pg8::Gemm g{BR, WO, ROWS_ACT, DM, DM};
        pg8::OrderExt S; S.init(NTOK, DM, F.G, F.bid, 0, 0, 0, 1);
        pg8::EpiOut E{Z0, 0, A0, Z0, STATS, F.in[17], F.in[18], ALPHA};
        pg8::gemm_phase<pg8::EpiOut, pg8::OrderExt, true, true>(F.lds, g, S, E);
        skinny_phase(F, BR + (size_t)ROW_S * DM, WO, DM, 256, SkStoreOut{Z0, 0, A0, Z0, STATS, F.in[17], F.in[18]});
    }
    SEAM(3);
    if (IN(4)) { for (int m = gw; m < NTOK + NDEC; m += NGW) ln_row(Z0 + (size_t)m * DM, F.in[17], F.in[18], H1 + (size_t)m * DM, nullptr, STATS + 2 * m, F.lane); }
    SEAM(4);
    if (IN(5)) {
        pg8::Gemm g{H1, WT1, ROWS_ACT, N1, DM};
        pg8::OrderExt S; S.init(NTOK, N1, F.G, F.bid, 0, 0, 0, 1);
        pg8::EpiProj E{U1, N1, N1 / 256, 0, F.out + O_MK, MKVB};
        pg8::gemm_phase<pg8::EpiProj, pg8::OrderExt, true, true>(F.lds, g, S, E);
        skinny_phase(F, H1 + (size_t)ROW_S * DM, WT1, N1, 256, SkStoreProj{U1, N1});
    }
    SEAM(5);
    if (IN(6)) {
        if (!(fl & 1)) hgrn_prep_phase(F);
    }
    SEAM(6);
    if (IN(7)) {
        const int nH = 96;
        if (F.G > nH) {
            if (F.bid < nH) { if (!(fl & 1)) hgrn_seq_unit(F, F.bid / 12, F.bid % 12, fl); }
            else if (!(fl & 2)) { const int nO = F.G - nH;
                for (int it = F.bid - nH; it < 256 + 512; it += nO) {
                    if (it < 256) { const int b = it >> 5, rem = it & 31; mem_prompt_unit(F, 1, b, rem >> 3, rem & 7, U1, N1, 4608, 5120); }
                    else mem_sample_unit(F, 1, (it - 256) >> 2, (it - 256) & 3, U1, N1, 4608, 5120); }
                for (int u = F.G - 1 - F.bid; u < NDEC * 12; u += nO) hgrn_sample_unit(F, u / 12, u % 12); }
        } else {
            for (int u = F.bid; u < nH; u += F.G) hgrn_seq_unit(F, u / 12, u % 12, fl);
            for (int it = F.bid; it < 256 + 512; it += F.G) {
                if (it < 256) { const int b = it >> 5, rem = it & 31; mem_prompt_unit(F, 1, b, rem >> 3, rem & 7, U1, N1, 4608, 5120); }
                else mem_sample_unit(F, 1, (it - 256) >> 2, (it - 256) & 3, U1, N1, 4608, 5120); }
            for (int u = F.bid; u < NDEC * 12; u += F.G) hgrn_sample_unit(F, u / 12, u % 12);
        }
    }
    SEAM(7);
    if (IN(8)) {
        pg8::Gemm g{BR, WO + (size_t)DM * DM, ROWS_ACT, DM, DM};
        pg8::OrderExt S; S.init(NTOK, DM, F.G, F.bid, 0, 0, 0, 1);
        pg8::EpiOut E{Z1, 1, A0, Z0, STATS, F.in[17], F.in[18], ALPHA};
        pg8::gemm_phase<pg8::EpiOut, pg8::OrderExt, true, true>(F.lds, g, S, E);
        skinny_phase(F, BR + (size_t)ROW_S * DM, WO + (size_t)DM * DM, DM, 256, SkStoreOut{Z1, 1, A0, Z0, STATS, F.in[17], F.in[18]});
    }
    SEAM(8);
    if (IN(9)) { for (int m = gw; m < NTOK + NDEC; m += NGW) ln_row(Z1 + (size_t)m * DM, F.in[17] + DM, F.in[18] + DM, nullptr, F.out + (size_t)m * DM, nullptr, F.lane); }
#undef IN
#undef SEAM
}

extern "C" void kernel_launch(void* const* d_in, const int* in_sizes, int n_in, void* d_out, int out_size, void* d_ws, size_t ws_size, hipStream_t stream) {
    static int grid = 0;
    if (grid == 0) {
        if (n_in != 19 || (size_t)out_size != O_END || ws_size < WS_END) { fprintf(stderr, "kernel_launch: unexpected shapes: n_in %d out %d ws %zu (need %zu)\n", n_in, out_size, ws_size, (size_t)WS_END); grid = -1; return; }
        int dev = 0, cus = 0, per_cu = 0;
        if (hipGetDevice(&dev) != hipSuccess || hipDeviceGetAttribute(&cus, hipDeviceAttributeMultiprocessorCount, dev) != hipSuccess) { grid = -1; return; }
        if (hipFuncSetAttribute((const void*)fwd_megakernel, hipFuncAttributeMaxDynamicSharedMemorySize, LDS_BYTES) != hipSuccess) { fprintf(stderr, "kernel_launch: hipFuncSetAttribute failed\n"); grid = -1; return; }
        if (hipOccupancyMaxActiveBlocksPerMultiprocessor(&per_cu, (const void*)fwd_megakernel, 512, LDS_BYTES) != hipSuccess || per_cu < 1) { fprintf(stderr, "kernel_launch: occupancy query failed (%d)\n", per_cu); (void)hipGetLastError(); per_cu = 1; }
        grid = cus * (per_cu < 1 ? 1 : 1);
        fprintf(stderr, "kernel_launch: grid %d (cus %d, per_cu %d)\n", grid, cus, per_cu);
    }
    if (grid < 0) return;
    if (hipMemsetAsync((char*)d_ws + WS_CTL, 0, CTL_ZERO_BYTES, stream) != hipSuccess) { fprintf(stderr, "kernel_launch: memset failed\n"); return; }
    Args a{};
    for (int i = 0; i < 19; ++i) a.in[i] = (const float*)d_in[i];
    a.out = (float*)d_out; a.ws = (unsigned char*)d_ws;
#if MK_PLAN == 0
    const int plan[][3] = {{0, N_PHASES, 0}};
#elif MK_PLAN == 1
    const int plan[][3] = {{0, 3, 0}, {2, 3, 0}, {3, 8, 0}, {6, 8, 0}, {8, N_PHASES, 0}};
#elif MK_PLAN == 2
    const int plan[][3] = {{0, 1, 0}, {0, 5, 0}, {4, N_PHASES, 0}};
#elif MK_PLAN == 3
    const int plan[][3] = {{0, 3, 0}, {3, 8, 0}, {6, 8, 0}, {8, N_PHASES, 0}};
#elif MK_PLAN == 4
    const int plan[][3] = {{0, 3, 0}, {2, 3, 0}, {3, N_PHASES, 0}};
#elif MK_PLAN == 5
    const int plan[][3] = {{0, 3, 0}, {3, 8, 0}, {8, N_PHASES, 0}};
#elif MK_PLAN == 6
    const int plan[][3] = {{0, 3, 0}, {3, 7, 0}, {6, 7, 0}, {7, N_PHASES, 0}};
#elif MK_PLAN == 7
    const int plan[][3] = {{0, 3, 0}, {3, 8, 0}, {7, 8, 0}, {8, N_PHASES, 0}};
#elif MK_PLAN == 8
    const int plan[][3] = {{0, 3, 0}, {2, 3, 8 + 16 + 32}, {3, N_PHASES, 0}};
#elif MK_PLAN == 9
    const int plan[][3] = {{0, 3, 0}, {2, 3, 4 + 16 + 32}, {3, N_PHASES, 0}};
#elif MK_PLAN == 11
    const int plan[][3] = {{0, 3, 0}, {3, 8, 0}, {7, 8, 2}, {8, N_PHASES, 0}};
#elif MK_PLAN == 12
    const int plan[][3] = {{0, 3, 0}, {3, 8, 0}, {7, 8, 1}, {8, N_PHASES, 0}};
#elif MK_PLAN == 13
    const int plan[][3] = {{0, 7, 0}, {7, 8, 2 + 64}, {7, 8, 0}, {8, N_PHASES, 0}};
#elif MK_PLAN == 14
    const int plan[][3] = {{0, 7, 0}, {7, 8, 2 + 128}, {7, 8, 0}, {8, N_PHASES, 0}};
#elif MK_PLAN == 15
    const int plan[][3] = {{0, 7, 0}, {7, 8, 2}, {7, 8, 0}, {8, N_PHASES, 0}};
#elif MK_PLAN == 16
    const int plan[][3] = {{0, 7, 0}, {7, 8, 2 + 64 + 256}, {7, 8, 0}, {8, N_PHASES, 0}};
#elif MK_PLAN == 17
    const int plan[][3] = {{0, 7, 0}, {7, 8, 2 + 64 + 128 + 512}, {7, 8, 0}, {8, N_PHASES, 0}};
#elif MK_PLAN == 18
    const int plan[][3] = {{0, 2, 0}, {1, 2, 0}, {2, 6, 0}, {5, 6, 0}, {6, N_PHASES, 0}};
#elif MK_PLAN == 19
    const int plan[][3] = {{0, 4, 0}, {3, 4, 0}, {4, 9, 0}, {8, 9, 0}, {9, N_PHASES, 0}};
#elif MK_PLAN == 20
    const int plan[][3] = {{0, 2, 0}, {2, 3, 4 + 16 + 32 + 1024}, {2, 3, 0}, {3, N_PHASES, 0}};
#elif MK_PLAN == 21
    const int plan[][3] = {{0, 2, 0}, {2, 3, 4 + 16 + 32 + 2048}, {2, 3, 0}, {3, N_PHASES, 0}};
#elif MK_PLAN == 22
    const int plan[][3] = {{0, 2, 0}, {2, 3, 4 + 16 + 32 + 4096}, {2, 3, 0}, {3, N_PHASES, 0}};
#elif MK_PLAN == 23
    const int plan[][3] = {{0, 2, 0}, {2, 3, 4 + 16 + 32 + 16384}, {2, 3, 0}, {3, N_PHASES, 0}};
#elif MK_PLAN == 24
    const int plan[][3] = {{0, 2, 0}, {2, 3, 4 + 16 + 32 + 4096 + 16384}, {2, 3, 0}, {3, N_PHASES, 0}};
#elif MK_PLAN == 25
    const int plan[][3] = {{0, 2, 0}, {2, 3, 4 + 16 + 32}, {2, 3, 0}, {3, N_PHASES, 0}};
#elif MK_PLAN == 10
    const int plan[][3] = {{0, 3, 0}, {2, 3, 4 + 8}, {3, N_PHASES, 0}};
#endif
    const int nl = (int)(sizeof(plan) / sizeof(plan[0]));
    for (int li = 0; li < nl; ++li) {
        a.ph_lo = plan[li][0]; a.ph_hi = plan[li][1]; a.li = li; a.flags = plan[li][2];
        void* kargs[] = {&a};
        hipError_t e = hipLaunchCooperativeKernel((const void*)fwd_megakernel, dim3(grid), dim3(512), kargs, LDS_BYTES, stream);
        if (e != hipSuccess) { fprintf(stderr, "kernel_launch: cooperative launch %d failed: %s (grid %d)\n", li, hipGetErrorString(e), grid); break; }
    }
}
```
